# Optimizing an MI355X kernel written in HIP

```python
import math
import jax, jax.numpy as jnp
from jax import lax
import numpy as np

D_MODEL = 1024
BATCH = 4
SEQ = 8192
DEPTH = 2

N_A_LAYERS = max(1, DEPTH // 2)
N_B_LAYERS = DEPTH - N_A_LAYERS

GMLP_DIM = 2 * D_MODEL
GMLP_CHUNK = 128
GMLP_GROUPS = 8
GMLP_GDIM = GMLP_DIM // GMLP_GROUPS

N_HEADS = 16
HEAD_DIM = 64
N_KV_GROUPS = 4
HEADS_PER_GROUP = N_HEADS // N_KV_GROUPS
N_BRANCH = 3
CMP_BLOCK = 32
CMP_STRIDE = 16
CMP_HIDDEN = 256
SEL_BLOCK = 64
SEL_TOP = 16
WINDOW = 512
Q_BLOCK = 64
N_KV_SLOTS = 6

REL_BUCKETS = 32
REL_MAX_DIST = 2048

N_EXPERTS = 32
TOP_K = 4
EXPERT_DIM = D_MODEL
SWIGLU_LIMIT = 7.0
SWIGLU_ALPHA = 1.702
MOE_BLOCK = 512

PLE_DIM = 256

NORM_EPS = 1e-6
NEG_INF = -1e30
FORCE = 1e30

kernel_name = "yoco_gmlp_nsa_moe_trunk"


def rms_norm(x, g):
    xf = x.astype(jnp.float32)
    y = xf * lax.rsqrt(jnp.mean(xf * xf, axis=-1, keepdims=True) + NORM_EPS)
    return (y * g.astype(jnp.float32)).astype(x.dtype)


def layer_norm(x, g, b):
    xf = x.astype(jnp.float32)
    mu = jnp.mean(xf, axis=-1, keepdims=True)
    xc = xf - mu
    y = xc * lax.rsqrt(jnp.mean(xc * xc, axis=-1, keepdims=True) + NORM_EPS)
    return (y * g.astype(jnp.float32) + b.astype(jnp.float32)).astype(x.dtype)


def t5_bucket(dist):
    n = jnp.maximum(dist, 0)
    max_exact = REL_BUCKETS // 2
    nf = jnp.maximum(n, 1).astype(jnp.float32)
    large = max_exact + (jnp.log(nf / max_exact) / math.log(REL_MAX_DIST / max_exact)
                         * (REL_BUCKETS - max_exact)).astype(jnp.int32)
    return jnp.where(n < max_exact, n, jnp.minimum(large, REL_BUCKETS - 1))


def gmlp_mixer(xn, w_in, ln_g, ln_b, w_s, b_s, w_out):
    B_, S_, _ = xn.shape
    z = jax.nn.gelu(xn @ w_in)
    u, v = jnp.split(z, 2, axis=-1)
    v = layer_norm(v, ln_g, ln_b)
    v = v.reshape(B_, S_ // GMLP_CHUNK, GMLP_CHUNK, GMLP_GROUPS, GMLP_GDIM)
    causal = jnp.tril(jnp.ones((GMLP_CHUNK, GMLP_CHUNK), dtype=w_s.dtype))
    mixed = jnp.einsum('gts,bcsgd->bctgd', w_s * causal, v) + jnp.transpose(b_s)[:, :, None]
    return (u * mixed.reshape(B_, S_, GMLP_DIM)) @ w_out


def shared_kv(h, kv_norm, kv_w, cmp_pos, cmp_w1, cmp_b1, cmp_w2, k_norm):
    B_, S_, _ = h.shape
    kv = (rms_norm(h, kv_norm) @ kv_w).reshape(B_, S_, N_KV_SLOTS, N_KV_GROUPS, HEAD_DIM)
    k_c, v_c, k_s, v_s, k_w, v_w = [kv[:, :, j] for j in range(N_KV_SLOTS)]
    n_cmp = (S_ - CMP_BLOCK) // CMP_STRIDE + 1
    blk_idx = np.arange(n_cmp)[:, None] * CMP_STRIDE + np.arange(CMP_BLOCK)[None, :]

    def compress(t, j):
        blocks = t[:, blk_idx] + cmp_pos[j][None, None, :, None, :]
        w1 = cmp_w1[j].reshape(CMP_BLOCK, HEAD_DIM, CMP_HIDDEN)
        hid = jax.nn.gelu(jnp.einsum('bnlgd,ldf->bngf', blocks, w1) + cmp_b1[j])
        return jnp.einsum('bngf,fd->bgnd', hid, cmp_w2[j])

    k_cmp = rms_norm(compress(k_c, 0), k_norm[0])
    v_cmp = compress(v_c, 1)
    n_sel = S_ // SEL_BLOCK

    def to_blocks(t):
        return jnp.transpose(t, (0, 2, 1, 3)).reshape(B_, N_KV_GROUPS, n_sel, SEL_BLOCK, HEAD_DIM)

    def pad_front(t):
        return jnp.pad(jnp.transpose(t, (0, 2, 1, 3)), ((0, 0), (0, 0), (WINDOW, 0), (0, 0)))

    return (k_cmp, v_cmp,
            to_blocks(rms_norm(k_s, k_norm[1])), to_blocks(v_s),
            pad_front(rms_norm(k_w, k_norm[2])), pad_front(v_w))


def gather_blocks(blocks, idx):
    return jax.vmap(jax.vmap(lambda bl, ix: bl[ix]))(blocks, idx)


def nsa_mixer(xn, w_in, b_gate, q_norm, w_out, rel_bias,
              k_cmp, v_cmp, k_sel, v_sel, k_win, v_win):
    B_, S_, _ = xn.shape
    HD = N_HEADS * HEAD_DIM
    proj = xn @ w_in
    q = proj[..., :HD].reshape(B_, S_, N_HEADS, HEAD_DIM)
    q = rms_norm(q, q_norm) * (HEAD_DIM ** -0.5)
    gates = jax.nn.sigmoid((proj[..., HD:] + b_gate).astype(jnp.float32))
    n_qb = S_ // Q_BLOCK
    n_cmp = k_cmp.shape[2]
    n_sel = S_ // SEL_BLOCK
    n_top = min(SEL_TOP, n_sel)
    q_blocks = q.reshape(B_, n_qb, Q_BLOCK, N_KV_GROUPS, HEADS_PER_GROUP, HEAD_DIM).transpose(1, 0, 2, 3, 4, 5)
    g_blocks = gates.reshape(B_, n_qb, Q_BLOCK, N_BRANCH, N_KV_GROUPS, HEADS_PER_GROUP).transpose(1, 0, 2, 3, 4, 5)

    cmp_start = np.arange(n_cmp) * CMP_STRIDE
    sel_start = np.arange(n_sel) * SEL_BLOCK
    overlap = np.clip(np.minimum(cmp_start[:, None] + CMP_BLOCK, sel_start[None, :] + SEL_BLOCK)
                      - np.maximum(cmp_start[:, None], sel_start[None, :]), 0, None)
    overlap = jnp.asarray((overlap / CMP_BLOCK).astype(np.float32))
    cmp_end = jnp.asarray(cmp_start + CMP_BLOCK - 1, dtype=jnp.int32)
    bias_tab = rel_bias.astype(jnp.float32).reshape(REL_BUCKETS, N_KV_GROUPS, HEADS_PER_GROUP)
    tab_gr = jnp.transpose(bias_tab, (1, 2, 0))
    sel_pos = jnp.arange(SEL_BLOCK, dtype=jnp.int32)
    blk_ids = jnp.arange(n_sel, dtype=jnp.int32)

    def head_bias(dist):
        return jnp.moveaxis(bias_tab[t5_bucket(dist)], (-2, -1), (0, 1))

    def block_fn(args):
        qb, gb, i = args
        t = i * Q_BLOCK + jnp.arange(Q_BLOCK, dtype=jnp.int32)
        s = jnp.einsum('bqgrd,bgnd->bgrqn', qb, k_cmp).astype(jnp.float32)
        dist = t[:, None] - cmp_end[None, :]
        s = jnp.where(dist >= 0, s + head_bias(dist), NEG_INF)
        p_c = jax.nn.softmax(s, axis=-1) * (t >= CMP_BLOCK - 1)[:, None]
        o_c = jnp.einsum('bgrqn,bgnd->bgrqd', p_c.astype(v_cmp.dtype), v_cmp)
        imp = jnp.einsum('bgrqn,ns->bgqs', p_c, overlap)
        cur = t // SEL_BLOCK
        forced = (blk_ids[None, :] == 0) | (blk_ids[None, :] == cur[:, None]) | (blk_ids[None, :] == cur[:, None] - 1)
        future = blk_ids[None, :] > cur[:, None]
        imp = jnp.where(forced, FORCE, jnp.where(future, NEG_INF, imp))
        _, idx = lax.top_k(imp, n_top)
        kg = gather_blocks(k_sel, idx)
        vg = gather_blocks(v_sel, idx)
        s = jnp.einsum('bqgrd,bgqkjd->bgrqkj', qb, kg).astype(jnp.float32)
        pos = idx[..., None] * SEL_BLOCK + sel_pos
        dist = t[None, None, :, None, None] - pos
        sel_bias = jax.vmap(lambda tg, bk: tg[:, bk], in_axes=(0, 1), out_axes=1)(tab_gr, t5_bucket(dist))
        sel_bias = jnp.transpose(sel_bias, (2, 1, 0, 3, 4, 5))
        s = jnp.where((dist >= 0)[:, :, None], s + sel_bias, NEG_INF)
        p_s = jax.nn.softmax(s.reshape(s.shape[:4] + (n_top * SEL_BLOCK,)), axis=-1).reshape(s.shape)
        o_s = jnp.einsum('bgrqkj,bgqkjd->bgrqd', p_s.astype(vg.dtype), vg)
        kw = lax.dynamic_slice_in_dim(k_win, i * Q_BLOCK, Q_BLOCK + WINDOW, axis=2)
        vw = lax.dynamic_slice_in_dim(v_win, i * Q_BLOCK, Q_BLOCK + WINDOW, axis=2)
        wpos = i * Q_BLOCK - WINDOW + jnp.arange(Q_BLOCK + WINDOW, dtype=jnp.int32)
        dist = t[:, None] - wpos[None, :]
        valid = (dist >= 0) & (dist < WINDOW) & (wpos >= 0)[None, :]
        s = jnp.einsum('bqgrd,bgld->bgrql', qb, kw).astype(jnp.float32)
        s = jnp.where(valid, s + head_bias(dist), NEG_INF)
        p_w = jax.nn.softmax(s, axis=-1)
        o_w = jnp.einsum('bgrql,bgld->bgrqd', p_w.astype(vw.dtype), vw)
        g = jnp.transpose(gb, (2, 0, 3, 4, 1))[..., None]
        o = (g[0] * o_c + g[1] * o_s + g[2] * o_w).astype(qb.dtype)
        return jnp.transpose(o, (0, 3, 1, 2, 4)).reshape(B_, Q_BLOCK, HD)

    out = lax.map(block_fn, (q_blocks, g_blocks, jnp.arange(n_qb, dtype=jnp.int32)))
    out = jnp.transpose(out, (1, 0, 2, 3)).reshape(B_, S_, HD)
    return out @ w_out


def moe(xn, router_w, router_b, w_gu, b_gu, w_d, b_d):
    B_, S_, D_ = xn.shape
    xt = xn.reshape(-1, D_)
    n_tok = xt.shape[0]
    logits = (xt @ router_w + router_b).astype(jnp.float32)
    top_val, top_idx = lax.top_k(logits, TOP_K)
    top_w = jax.nn.softmax(top_val, axis=-1)
    n_asg = n_tok * TOP_K
    e_flat = top_idx.reshape(-1).astype(jnp.int32)
    tok_flat = jnp.arange(n_asg, dtype=jnp.int32) // TOP_K
    w_flat = top_w.reshape(-1)
    e_sorted, order = lax.sort((e_flat, jnp.arange(n_asg, dtype=jnp.int32)), num_keys=1, is_stable=True)
    tok_sorted = tok_flat[order]
    w_sorted = w_flat[order]
    counts = jnp.bincount(e_flat, length=N_EXPERTS)
    starts = jnp.cumsum(counts) - counts
    pad_counts = (counts + MOE_BLOCK - 1) // MOE_BLOCK * MOE_BLOCK
    pad_ends = jnp.cumsum(pad_counts)
    pad_starts = pad_ends - pad_counts
    dest = pad_starts[e_sorted] + jnp.arange(n_asg, dtype=jnp.int32) - starts[e_sorted]
    n_blk = -(-n_asg // MOE_BLOCK) + N_EXPERTS
    n_rows = n_blk * MOE_BLOCK
    row_tok = jnp.zeros((n_rows,), jnp.int32).at[dest].set(tok_sorted)
    row_w = jnp.zeros((n_rows,), jnp.float32).at[dest].set(w_sorted)
    blk_expert = jnp.minimum(jnp.searchsorted(pad_ends, jnp.arange(n_blk, dtype=jnp.int32) * MOE_BLOCK, side='right'),
                             N_EXPERTS - 1)

    def expert_block(args):
        tok, w, e = args
        gu = xt[tok] @ w_gu[e] + b_gu[e]
        gate, up = jnp.split(gu, 2, axis=-1)
        gate = jnp.minimum(gate, SWIGLU_LIMIT)
        up = jnp.clip(up, -SWIGLU_LIMIT, SWIGLU_LIMIT)
        glu = gate * jax.nn.sigmoid(gate * SWIGLU_ALPHA)
        y = ((up + 1.0) * glu) @ w_d[e] + b_d[e]
        return y * w[:, None].astype(y.dtype)

    ys = lax.map(expert_block, (row_tok.reshape(n_blk, MOE_BLOCK), row_w.reshape(n_blk, MOE_BLOCK), blk_expert))
    out = jax.ops.segment_sum(ys.reshape(n_rows, D_), row_tok, num_segments=n_tok)
    return out.reshape(B_, S_, D_)


def setup_inputs(seed: int = 0) -> dict:
    key = jax.random.key(seed)
    ks = iter(jax.random.split(key, 40))
    f32 = jnp.float32

    def nrm(shape, scale):
        return jax.random.normal(next(ks), shape, f32) * scale

    def gain(shape):
        return 1.0 + nrm(shape, 0.1)

    HD = N_HEADS * HEAD_DIM
    return {
        "x": nrm((BATCH, SEQ, D_MODEL), 1.0),
        "p": nrm((DEPTH, BATCH, SEQ, PLE_DIM), 1.0),
        "rel_bias": nrm((REL_BUCKETS, N_HEADS), 0.5),
        "norm_mix": gain((DEPTH, D_MODEL)),
        "norm_ffn": gain((DEPTH, D_MODEL)),
        "a_w_in": nrm((N_A_LAYERS, D_MODEL, 2 * GMLP_DIM), D_MODEL ** -0.5),
        "a_ln_g": gain((N_A_LAYERS, GMLP_DIM)),
        "a_ln_b": nrm((N_A_LAYERS, GMLP_DIM), 0.1),
        "a_w_s": nrm((N_A_LAYERS, GMLP_GROUPS, GMLP_CHUNK, GMLP_CHUNK), GMLP_CHUNK ** -0.5),
        "a_b_s": gain((N_A_LAYERS, GMLP_GROUPS, GMLP_CHUNK)),
        "a_w_out": nrm((N_A_LAYERS, GMLP_DIM, D_MODEL), GMLP_DIM ** -0.5),
        "kv_norm": gain((D_MODEL,)),
        "kv_w": nrm((D_MODEL, N_KV_SLOTS * N_KV_GROUPS * HEAD_DIM), D_MODEL ** -0.5),
        "cmp_pos": nrm((2, CMP_BLOCK, HEAD_DIM), 0.1),
        "cmp_w1": nrm((2, CMP_BLOCK * HEAD_DIM, CMP_HIDDEN), (CMP_BLOCK * HEAD_DIM) ** -0.5),
        "cmp_b1": nrm((2, CMP_HIDDEN), 0.01),
        "cmp_w2": nrm((2, CMP_HIDDEN, HEAD_DIM), CMP_HIDDEN ** -0.5),
        "k_norm": gain((N_BRANCH, HEAD_DIM)),
        "b_w_in": nrm((N_B_LAYERS, D_MODEL, HD + N_BRANCH * N_HEADS), D_MODEL ** -0.5),
        "b_b_gate": nrm((N_B_LAYERS, N_BRANCH * N_HEADS), 0.1),
        "q_norm": gain((N_B_LAYERS, HEAD_DIM)),
        "b_w_out": nrm((N_B_LAYERS, HD, D_MODEL), HD ** -0.5),
        "router_w": nrm((DEPTH, D_MODEL, N_EXPERTS), D_MODEL ** -0.5),
        "router_b": nrm((DEPTH, N_EXPERTS), 0.01),
        "e_w_gu": nrm((DEPTH, N_EXPERTS, D_MODEL, 2 * EXPERT_DIM), D_MODEL ** -0.5),
        "e_b_gu": nrm((DEPTH, N_EXPERTS, 2 * EXPERT_DIM), 0.01),
        "e_w_d": nrm((DEPTH, N_EXPERTS, EXPERT_DIM, D_MODEL), EXPERT_DIM ** -0.5),
        "e_b_d": nrm((DEPTH, N_EXPERTS, D_MODEL), 0.01),
        "ple_w": nrm((DEPTH, PLE_DIM, D_MODEL), PLE_DIM ** -0.5),
        "ple_gate_w": nrm((DEPTH, D_MODEL, D_MODEL), D_MODEL ** -0.5),
        "ple_norm": gain((DEPTH, D_MODEL)),
    }


def reference(x, p, rel_bias, norm_mix, norm_ffn, a_w_in, a_ln_g, a_ln_b, a_w_s, a_b_s, a_w_out,
              kv_norm, kv_w, cmp_pos, cmp_w1, cmp_b1, cmp_w2, k_norm,
              b_w_in, b_b_gate, q_norm, b_w_out,
              router_w, router_b, e_w_gu, e_b_gu, e_w_d, e_b_d,
              ple_w, ple_gate_w, ple_norm):
    h = x
    kv = None
    for i in range(DEPTH):
        xn = rms_norm(h, norm_mix[i])
        if i < N_A_LAYERS:
            h = h + gmlp_mixer(xn, a_w_in[i], a_ln_g[i], a_ln_b[i], a_w_s[i], a_b_s[i], a_w_out[i])
        else:
            j = i - N_A_LAYERS
            h = h + nsa_mixer(xn, b_w_in[j], b_b_gate[j], q_norm[j], b_w_out[j], rel_bias, *kv)
        h = h + moe(rms_norm(h, norm_ffn[i]), router_w[i], router_b[i], e_w_gu[i], e_b_gu[i], e_w_d[i], e_b_d[i])
        h = h + (p[i] @ ple_w[i]) * jax.nn.sigmoid(rms_norm(h, ple_norm[i]) @ ple_gate_w[i])
        if i == N_A_LAYERS - 1:
            kv = shared_kv(h, kv_norm, kv_w, cmp_pos, cmp_w1, cmp_b1, cmp_w2, k_norm)
    return h
```

```cpp
#include <hip/hip_runtime.h>
#include <cstdio>
#include <cstdint>

#ifndef PROBE_ATT
#define PROBE_ATT 0
#endif
#ifndef PROBE_EREP
#define PROBE_EREP 0
#endif
#ifndef PROBE_KREP
#define PROBE_KREP 1
#endif
#ifndef PHASE_PLAN
#define PHASE_PLAN 0, 19
#endif

#define GAS __attribute__((address_space(1)))
#define LAS __attribute__((address_space(3)))
typedef unsigned short bf16;
typedef short bf16x8 __attribute__((ext_vector_type(8)));
typedef float f32x4 __attribute__((ext_vector_type(4)));
typedef float f32x2 __attribute__((ext_vector_type(2)));
typedef float f32x16 __attribute__((ext_vector_type(16)));
typedef unsigned u32x4 __attribute__((ext_vector_type(4)));
typedef unsigned u32x2 __attribute__((ext_vector_type(2)));
typedef int i32x4 __attribute__((ext_vector_type(4)));
typedef int i32x8 __attribute__((ext_vector_type(8)));

constexpr int NB = 4, SEQ = 8192, D = 1024, NTOK = NB * SEQ;
constexpr int GD = 2048;
constexpr int NEXP = 32, TOPK = 4, NASG = NTOK * TOPK;
constexpr int PLE = 256;
constexpr int NKVG = 4, HD = 64, NHEAD = 16;
constexpr int NCMP = 511, NCMPP = 512, NSEL = 128;
constexpr float EPS = 1e-6f;
constexpr int NKVQ = 2816;
constexpr int ACT_ROWS = NASG + NEXP * 256;

constexpr size_t MiB = 1u << 20;
constexpr size_t WS_CTL = 0, CTL_ZERO_BYTES = 1 * MiB;
constexpr size_t WS_SSQ1 = 1 * MiB;
constexpr size_t WS_SSQ16 = 2 * MiB;
constexpr size_t WS_LNP = 8 * MiB;
constexpr size_t WS_WAIN = 16 * MiB;
constexpr size_t WS_WAOUT = 24 * MiB;
constexpr size_t WS_WKVQ = 28 * MiB;
constexpr size_t WS_WO = 34 * MiB;
constexpr size_t WS_WPG = 36 * MiB;
constexpr size_t WS_WPL = 40 * MiB;
constexpr size_t WS_WC1 = 41 * MiB;
constexpr size_t WS_WAS = 43 * MiB;
constexpr size_t WS_CB1 = 43 * MiB + 512 * 1024;
constexpr size_t WS_WGU = 44 * MiB;
constexpr size_t WS_WD = 300 * MiB;
constexpr size_t WS_PB = 428 * MiB;
constexpr size_t WS_HF = 460 * MiB;
constexpr size_t WS_HB0 = 588 * MiB;
constexpr size_t WS_HB1 = 652 * MiB;
constexpr size_t WS_U = 716 * MiB;
constexpr size_t WS_V = 844 * MiB;
constexpr size_t WS_ACT = 972 * MiB;
constexpr size_t WS_Y = 1244 * MiB;
constexpr size_t WS_PW = 1500 * MiB;
constexpr size_t WS_KSEL = 1628 * MiB;
constexpr size_t WS_KWIN = 1644 * MiB;
constexpr size_t WS_KC = 1660 * MiB;
constexpr size_t WS_VC = 1678 * MiB;
constexpr size_t WS_VSEL = 1696 * MiB;
constexpr size_t WS_VWIN = 1712 * MiB;
constexpr size_t WS_VTSEL = 1728 * MiB;
constexpr size_t WS_VTWIN = 1744 * MiB;
constexpr size_t WS_Q = 1760 * MiB;
constexpr size_t WS_GATES = 1824 * MiB;
constexpr size_t WS_HID = 1830 * MiB;
constexpr size_t WS_KCMP = 1838 * MiB;
constexpr size_t WS_VTCMP = 1839 * MiB;
constexpr size_t WS_AO = 1840 * MiB;
constexpr size_t WS_LSLOT = 1904 * MiB;
constexpr size_t WS_LW = 1908 * MiB;
constexpr size_t WS_LRS = 1912 * MiB;
constexpr size_t WS_TRASH = 1916 * MiB;
constexpr size_t WS_HQ = 1917 * MiB;
constexpr size_t WS_HQ2 = 1949 * MiB;
constexpr size_t WS_HQ3 = 1981 * MiB;
constexpr size_t WS_AOQ = 2013 * MiB;
constexpr size_t WS_END = 2045 * MiB;

constexpr int CW_BAR = 4096;
constexpr int CW_CNT = 32768;

constexpr int LDS_BYTES = 163840;
constexpr int LDS_STAGE = 0;
constexpr int LDS_AUX = 131072;
constexpr int LDS_MISC = LDS_BYTES - 256;

constexpr int NWAVES = 8, NTHR = 512;

__device__ __forceinline__ unsigned f2bf(float f) { unsigned u = __builtin_bit_cast(unsigned, f); return (u + 0x7fffu + ((u >> 16) & 1u)) >> 16; }
typedef __bf16 bf16x2_t __attribute__((ext_vector_type(2)));
__device__ __forceinline__ unsigned pk2(float lo, float hi) { const f32x2 v = {lo, hi}; return __builtin_bit_cast(unsigned, __builtin_convertvector(v, bf16x2_t)); }
__device__ __forceinline__ float bf2f(unsigned short b) { return __builtin_bit_cast(float, (unsigned)b << 16); }
__device__ __forceinline__ float bflo(unsigned w) { return __builtin_bit_cast(float, w << 16); }
__device__ __forceinline__ float bfhi(unsigned w) { return __builtin_bit_cast(float, w & 0xffff0000u); }
__device__ __forceinline__ unsigned pk4_fp8(float a, float b, float c, float d) { int r = 0; r = __builtin_amdgcn_cvt_pk_fp8_f32(a, b, r, false); r = __builtin_amdgcn_cvt_pk_fp8_f32(c, d, r, true); return (unsigned)r; }
constexpr float F8_SA = 8.0f, F8_SW = 256.0f, F8_SACT = 4.0f, F8_SY = 16.0f;
__device__ __forceinline__ int lane_id() { int l; asm volatile("v_mbcnt_lo_u32_b32 %0, -1, 0\n\tv_mbcnt_hi_u32_b32 %0, -1, %0" : "=v"(l)); return l; }
#define DPP_F(v, ctrl) __builtin_bit_cast(float, __builtin_amdgcn_update_dpp(0, __builtin_bit_cast(int, (v)), (ctrl), 0xF, 0xF, false))
__device__ __forceinline__ float wave_sum(float v) {
    v += DPP_F(v, 0xB1); v += DPP_F(v, 0x4E); v += DPP_F(v, 0x141); v += DPP_F(v, 0x140);
    return __builtin_bit_cast(float, __builtin_amdgcn_readlane(__builtin_bit_cast(int, v), 0)) + __builtin_bit_cast(float, __builtin_amdgcn_readlane(__builtin_bit_cast(int, v), 16))
         + (__builtin_bit_cast(float, __builtin_amdgcn_readlane(__builtin_bit_cast(int, v), 32)) + __builtin_bit_cast(float, __builtin_amdgcn_readlane(__builtin_bit_cast(int, v), 48)));
}
__device__ __forceinline__ float xsum16(float s) { float a = s, b = s; asm("s_nop 1\n\tv_permlane16_swap_b32 %0, %1" : "+v"(a), "+v"(b)); return a + b; }
__device__ __forceinline__ void swap16(unsigned& a, unsigned& b) { asm("s_nop 1\n\tv_permlane16_swap_b32 %0, %1" : "+v"(a), "+v"(b)); }
__device__ __forceinline__ float xsum32(float s) { float a = s, b = s; asm("s_nop 1\n\tv_permlane32_swap_b32 %0, %1" : "+v"(a), "+v"(b)); return a + b; }
__device__ __forceinline__ float fast_exp2(float x) { return __builtin_amdgcn_exp2f(x); }
__device__ __forceinline__ float fast_rcp(float x) { return __builtin_amdgcn_rcpf(x); }
__device__ __forceinline__ float sigmoidf_(float x) { return fast_rcp(1.0f + fast_exp2(-1.44269504089f * x)); }
__device__ __forceinline__ float gelu_tanh(float x) {
    const float t = x * (2.302208198f + 0.1029432397f * x * x);
    return x * fast_rcp(1.0f + fast_exp2(-t));
}
__device__ __forceinline__ f32x2 gelu_tanh2(f32x2 x) {
    const f32x2 p = __builtin_elementwise_fma(x * x, (f32x2){-0.1029432397f, -0.1029432397f}, (f32x2){-2.302208198f, -2.302208198f}), t = x * p;
    const f32x2 d = (f32x2){fast_exp2(t.x), fast_exp2(t.y)} + (f32x2){1.0f, 1.0f};
    return x * (f32x2){fast_rcp(d.x), fast_rcp(d.y)};
}
__device__ __forceinline__ float rstd_of(float ssq) { return __builtin_amdgcn_rsqf(ssq * (1.0f / D) + EPS); }
__device__ __forceinline__ float rstd16(const float* p) {
    const f32x4 a = *(const f32x4*)p, b = *(const f32x4*)(p + 4), c = *(const f32x4*)(p + 8), d = *(const f32x4*)(p + 12);
    const f32x4 s = (a + b) + (c + d);
    return rstd_of((s.x + s.y) + (s.z + s.w));
}

#define XB_TMO      128
#define XB_XCNT(j)  (256  + 64 * (j))
#define XB_XSUB(j)  (1280 + 64 * (j))
#define XB_XGEN(j)  (2304 + 64 * (j))
#define XB_TOP      3328
#define XB_TOPGEN   3392
#define XCD_BAR_WORDS 3456
#define XB_SPIN_CAP (1u << 18)
__device__ __forceinline__ unsigned xb_ld(unsigned* p)              { return __hip_atomic_load(p, __ATOMIC_RELAXED, __HIP_MEMORY_SCOPE_AGENT); }
__device__ __forceinline__ unsigned xb_add(unsigned* p, unsigned v) { return __hip_atomic_fetch_add(p, v, __ATOMIC_RELAXED, __HIP_MEMORY_SCOPE_AGENT); }
__device__ __forceinline__ unsigned xb_xcc_id() { return (unsigned)__builtin_amdgcn_s_getreg((3 << 11) | 20) & 0xFu; }
#define XB_SPIN(cond, bar) do { unsigned _sp = 0; while (cond) { __builtin_amdgcn_s_sleep(1); \
    if ((++_sp & 255u) == 0u) { if (xb_ld(&(bar)[XB_TMO])) break; if (_sp > XB_SPIN_CAP) { atomicAdd(&(bar)[XB_TMO], 1u); break; } } } } while (0)
struct XcdBarrier { unsigned* bar; unsigned x; volatile LAS unsigned* st; int wave; };
__device__ __forceinline__ XcdBarrier xcd_barrier_post(unsigned* bar, volatile LAS unsigned* st, int wave) {
    XcdBarrier b; b.bar = bar; b.x = xb_xcc_id(); b.st = st; b.wave = wave;
    if (wave == 0 && lane_id() == 0) (void)xb_add(&bar[XB_XCNT(b.x)], 1u);
    return b;
}
__device__ __forceinline__ void xcd_barrier_complete(unsigned* bar, unsigned x, unsigned& nloc, unsigned& nx) {
    const unsigned G = gridDim.x * gridDim.y * gridDim.z;
    unsigned sum, cnt, mine, sp = 0u;
    for (;;) {
        sum = 0u; cnt = 0u; mine = 0u;
#pragma unroll
        for (unsigned j = 0; j < 16; ++j) { const unsigned c = xb_ld(&bar[XB_XCNT(j)]); sum += c; cnt += (c > 0u) ? 1u : 0u; mine = (j == x) ? c : mine; }
        if (sum == G) break;
        __builtin_amdgcn_s_sleep(1);
        if ((++sp & 255u) == 0u) { if (xb_ld(&bar[XB_TMO])) break; if (sp > XB_SPIN_CAP) { atomicAdd(&bar[XB_TMO], 1u); break; } }
    }
    nloc = mine > 0u ? mine : 1u; nx = cnt > 0u ? cnt : 1u;
}
__device__ __forceinline__ void xcd_barrier(const XcdBarrier& b) {
    asm volatile("s_waitcnt vmcnt(0)" ::: "memory");
    __syncthreads();
    if (b.wave == 0 && lane_id() == 0) {
        unsigned* bar = b.bar;
        __builtin_amdgcn_s_waitcnt(0);
        unsigned nloc = b.st[0], nx = b.st[1];
        if (nloc == 0u) { xcd_barrier_complete(bar, b.x, nloc, nx); b.st[0] = nloc; b.st[1] = nx; }
        const unsigned old = xb_add(&bar[XB_XSUB(b.x)], 1u);
        const unsigned gen = old / nloc;
        if (old + 1u == (gen + 1u) * nloc) {
            __builtin_amdgcn_fence(__ATOMIC_RELEASE, "agent");
            asm volatile("s_waitcnt vmcnt(0)" ::: "memory");
            const unsigned og = xb_add(&bar[XB_TOP], 1u);
            const unsigned tg = og / nx;
            if (og + 1u == (tg + 1u) * nx) xb_add(&bar[XB_TOPGEN], 1u);
            else XB_SPIN(xb_ld(&bar[XB_TOPGEN]) == tg, bar);
            __builtin_amdgcn_fence(__ATOMIC_ACQUIRE, "agent");
            xb_add(&bar[XB_XGEN(b.x)], 1u);
            asm volatile("s_waitcnt vmcnt(0)" ::: "memory");
        } else {
            XB_SPIN(xb_ld(&bar[XB_XGEN(b.x)]) == gen, bar);
            __builtin_amdgcn_fence(__ATOMIC_ACQUIRE, "agent");
            asm volatile("s_waitcnt vmcnt(0)" ::: "memory");
        }
    }
    __syncthreads();
}

namespace g8 {
constexpr int BM = 256, BK = 64, HALF = 128, HTB = HALF * BK * 2, STAGE_BYTES = 8 * HTB, NXCD = 8;
__device__ __forceinline__ int lds_byte(int r, int c) { const int st = (r >> 4) * 2 + (c >> 5), rr = r & 15, cc = c & 31, ob = rr * 64 + cc * 2; return st * 1024 + (ob ^ (((ob >> 9) & 1) << 5)); }
__device__ __forceinline__ void stage_rc(int b, int& R, int& C) { const int st = b / 1024, sb = b % 1024, swz = sb ^ (((sb >> 9) & 1) << 5); R = (st >> 1) * 16 + swz / 64; C = (st & 1) * 32 + (swz % 64) / 2; }
__host__ __device__ __forceinline__ int perm32(int rho) { const int n = rho >> 4, i = rho & 15; return 8 * (i >> 2) + 4 * n + (i & 3); }

struct Unit { int pm, pn, e, pos0, cnt; };

template <class Epi, class Sched, bool GATHER, bool F8 = false>
__device__ __forceinline__ void gemm_phase(LAS unsigned char* lds, const int K, const int lda, const Sched& S, const Epi& E, const int wid) {
    const int lane = lane_id(), tid = wid * 64 + lane, wr = wid >> 2, wc = wid & 3, fr = lane & 15, fq = lane >> 4;
    const int nt = K / BK;
    int Rr[2], Cc[2];
#pragma unroll
    for (int i = 0; i < 2; ++i) stage_rc(tid * 16 + i * 8192, Rr[i], Cc[i]);
    unsigned voB0, voA[2][2], voAn[2][2];
    voB0 = (unsigned)(Rr[0] * K + Cc[0]) * 2u; const unsigned voA0 = (unsigned)(Rr[0] * lda + Cc[0]) * 2u;
#pragma unroll
    for (int h = 0; h < 2; ++h)
#pragma unroll
        for (int i = 0; i < 2; ++i) { voA[h][i] = (unsigned)((h * HALF + Rr[i]) * lda + Cc[i]) * 2u; voAn[h][i] = voA[h][i]; }
    const size_t kstep = (size_t)(BK * 2);
    const unsigned ldsw = (unsigned)wid * 1024u;
    const int aoff = lds_byte(wr * 64 + fr, fq * 8), boff = lds_byte(wc * 32 + fr, fq * 8);
#define G8_SA(b, h) (((b) * 2 + (h)) * HTB)
#define G8_SB(b, h) ((4 + (b) * 2 + (h)) * HTB)
#define G8_UNI(p) ((const char*)(((unsigned long long)(unsigned)__builtin_amdgcn_readfirstlane((int)((unsigned long long)(p) >> 32)) << 32) | (unsigned)__builtin_amdgcn_readfirstlane((int)(unsigned long long)(p))))
#define G8_STAGE(bufoff, gbase, voff) do { const char* _ub = G8_UNI(gbase); _Pragma("unroll") for (int _i = 0; _i < 2; ++_i) \
        __builtin_amdgcn_global_load_lds((const unsigned*)(_ub + (voff)[_i]), (LAS unsigned*)(lds + (bufoff) + ldsw + _i * 8192), 16, 0, 0); } while (0)
#define G8_STAGEB(bufoff, gbase, h) do { const char* _ub = G8_UNI((const char*)(gbase) + (size_t)(h) * HALF * K * 2); _Pragma("unroll") for (int _i = 0; _i < 2; ++_i) \
        __builtin_amdgcn_global_load_lds((const unsigned*)(_ub + (size_t)_i * 64 * K * 2 + voB0), (LAS unsigned*)(lds + (bufoff) + ldsw + _i * 8192), 16, 0, 0); } while (0)
#define G8_STAGEA(bufoff, gbase, vo, h) do { if constexpr (GATHER) { G8_STAGE(bufoff, gbase, (vo)[h]); } else { const char* _ua = G8_UNI((const char*)(gbase) + (size_t)(h) * HALF * lda * 2); _Pragma("unroll") for (int _i = 0; _i < 2; ++_i) \
        __builtin_amdgcn_global_load_lds((const unsigned*)(_ua + (size_t)_i * 64 * lda * 2 + voA0), (LAS unsigned*)(lds + (bufoff) + ldsw + _i * 8192), 16, 0, 0); } } while (0)
#define G8_LDA(dst, b, h) do { _Pragma("unroll") for (int m = 0; m < 4; ++m) _Pragma("unroll") for (int k = 0; k < 2; ++k) dst[m][k] = *(const LAS bf16x8*)(lds + G8_SA(b, h) + aoff + m * 2048 + k * 1024); } while (0)
#define G8_LDB(dst, b, h) do { _Pragma("unroll") for (int n = 0; n < 2; ++n) _Pragma("unroll") for (int k = 0; k < 2; ++k) dst[n][k] = *(const LAS bf16x8*)(lds + G8_SB(b, h) + boff + n * 2048 + k * 1024); } while (0)
#define G8_CAT(x) __builtin_shufflevector(__builtin_bit_cast(i32x4, (x)[0]), __builtin_bit_cast(i32x4, (x)[1]), 0, 1, 2, 3, 4, 5, 6, 7)
#define G8_MMA(ai, bj, At, Bt) do { __builtin_amdgcn_s_setprio(1); _Pragma("unroll") for (int m = 0; m < 4; ++m) _Pragma("unroll") for (int n = 0; n < 2; ++n) { \
        if constexpr (F8) acc[ai][bj][m][n] = __builtin_amdgcn_mfma_scale_f32_16x16x128_f8f6f4(G8_CAT(Bt[n]), G8_CAT(At[m]), acc[ai][bj][m][n], 0, 0, 0, 0x7f7f7f7f, 0, 0x7f7f7f7f); \
        else { _Pragma("unroll") for (int k = 0; k < 2; ++k) acc[ai][bj][m][n] = __builtin_amdgcn_mfma_f32_16x16x32_bf16(Bt[n][k], At[m][k], acc[ai][bj][m][n], 0, 0, 0); } } __builtin_amdgcn_s_setprio(0); } while (0)
#define G8_WAIT_V(n) asm volatile("s_waitcnt vmcnt(" #n ")" ::: "memory")
#define G8_WAIT_L(n) asm volatile("s_waitcnt lgkmcnt(" #n ")" ::: "memory")
#define G8_BAR __builtin_amdgcn_s_barrier()
#define G8_SCHED __builtin_amdgcn_sched_barrier(0)
    Unit cur, nxt, nx2; int ui = 0;
    if (!S.next(0, cur)) return;
    bool has_next = S.next(1, nxt);
    if constexpr (GATHER) {
#pragma unroll
        for (int h = 0; h < 2; ++h)
#pragma unroll
            for (int i = 0; i < 2; ++i) { voA[h][i] = (unsigned)(S.row_off(cur, h * HALF + Rr[i]) + Cc[i] * 2); voAn[h][i] = has_next ? (unsigned)(S.row_off(nxt, h * HALF + Rr[i]) + Cc[i] * 2) : voA[h][i]; }
    }
    f32x4 acc[2][2][4][2];
#pragma unroll
    for (int a = 0; a < 2; ++a)
#pragma unroll
        for (int b = 0; b < 2; ++b)
#pragma unroll
            for (int m = 0; m < 4; ++m)
#pragma unroll
                for (int n = 0; n < 2; ++n) acc[a][b][m][n] = (f32x4){0.f, 0.f, 0.f, 0.f};
    bf16x8 At[4][2], B0[2][2], B1[2][2];
    const char* cA = S.a_ptr(cur); const char* cB = S.b_ptr(cur);
    G8_STAGEB(G8_SB(0, 0), cB, 0); G8_STAGEB(G8_SB(0, 1), cB, 1); G8_STAGEA(G8_SA(0, 0), cA, voA, 0); G8_STAGEA(G8_SA(0, 1), cA, voA, 1);
    if (wr == 1) G8_BAR;
    G8_WAIT_V(2); G8_BAR;
    G8_STAGEB(G8_SB(1, 0), cB + kstep, 0); G8_STAGEA(G8_SA(1, 0), cA + kstep, voA, 0); G8_STAGEB(G8_SB(1, 1), cB + kstep, 1);
    G8_WAIT_V(6); G8_BAR;
    for (;;) {
        const char* nA = has_next ? S.a_ptr(nxt) : cA; const char* nB = has_next ? S.b_ptr(nxt) : cB;
        for (int krep = 0; krep < PROBE_KREP; ++krep)
#pragma clang loop unroll(disable)
        for (int t = 0; t < nt; t += 2) {
            const bool last = (t == nt - 2); const bool lastrep = (krep == PROBE_KREP - 1);
            const char* a1 = cA + (size_t)(t + 1) * kstep;
            const char* a2 = last ? (lastrep ? nA : cA) : cA + (size_t)(t + 2) * kstep; const char* b2 = last ? (lastrep ? nB : cB) : cB + (size_t)(t + 2) * kstep;
            const char* a3 = a2 + kstep; const char* b3 = b2 + kstep;
            unsigned vx[2][2];
#pragma unroll
            for (int h = 0; h < 2; ++h)
#pragma unroll
                for (int i = 0; i < 2; ++i) vx[h][i] = (GATHER && last && lastrep) ? voAn[h][i] : voA[h][i];
            G8_LDB(B0, 0, 0); G8_LDB(B1, 0, 1); G8_SCHED; G8_LDA(At, 0, 0); G8_STAGEA(G8_SA(1, 1), a1, voA, 1);
            G8_WAIT_V(8); G8_WAIT_L(0); G8_BAR; G8_MMA(0, 0, At, B0); G8_MMA(0, 1, At, B1); G8_BAR; G8_SCHED;
            G8_LDA(At, 0, 1); G8_STAGEB(G8_SB(0, 0), b2, 0); G8_STAGEB(G8_SB(0, 1), b2, 1); G8_STAGEA(G8_SA(0, 0), a2, vx, 0);
            G8_WAIT_V(8); G8_WAIT_L(0); G8_BAR; G8_MMA(1, 0, At, B0); G8_MMA(1, 1, At, B1); G8_BAR; G8_SCHED;
            G8_LDB(B0, 1, 0); G8_LDB(B1, 1, 1); G8_SCHED; G8_LDA(At, 1, 0); G8_STAGEA(G8_SA(0, 1), a2, vx, 1);
            G8_WAIT_V(8); G8_WAIT_L(0); G8_BAR; G8_MMA(0, 0, At, B0); G8_MMA(0, 1, At, B1); G8_BAR; G8_SCHED;
            G8_LDA(At, 1, 1); G8_STAGEB(G8_SB(1, 0), b3, 0); G8_STAGEB(G8_SB(1, 1), b3, 1); G8_STAGEA(G8_SA(1, 0), a3, vx, 0);
            G8_WAIT_V(8); G8_WAIT_L(0); G8_BAR; G8_MMA(1, 0, At, B0); G8_MMA(1, 1, At, B1); G8_BAR; G8_SCHED;
        }
        if (wr == 0) G8_BAR;
        if (PROBE_KREP == 2) {
#pragma unroll
            for (int a = 0; a < 2; ++a)
#pragma unroll
                for (int b = 0; b < 2; ++b)
#pragma unroll
                    for (int m = 0; m < 4; ++m)
#pragma unroll
                        for (int n = 0; n < 2; ++n) acc[a][b][m][n] = acc[a][b][m][n] * 0.5f;
        }
        { const int l2 = lane_id(); E(acc, cur, wr, wc, l2 & 15, l2 >> 4); }
        if constexpr (F8 && PROBE_EREP) { asm volatile("" ::: "memory"); E(acc, cur, wr, wc, fr, fq); }
        if (!has_next) break;
        const bool has2 = S.next(ui + 2, nx2);
        if constexpr (GATHER) {
            int ro[2][2];
#pragma unroll
            for (int h = 0; h < 2; ++h)
#pragma unroll
                for (int i = 0; i < 2; ++i) ro[h][i] = S.row_off(has2 ? nx2 : nxt, h * HALF + Rr[i]);
#pragma unroll
            for (int h = 0; h < 2; ++h)
#pragma unroll
                for (int i = 0; i < 2; ++i) { voA[h][i] = voAn[h][i]; voAn[h][i] = (unsigned)(ro[h][i] + Cc[i] * 2); }
        }
#pragma unroll
        for (int a = 0; a < 2; ++a)
#pragma unroll
            for (int b = 0; b < 2; ++b)
#pragma unroll
                for (int m = 0; m < 4; ++m)
#pragma unroll
                    for (int n = 0; n < 2; ++n) acc[a][b][m][n] = (f32x4){0.f, 0.f, 0.f, 0.f};
        cur = nxt; cA = nA; cB = nB; ++ui; nxt = nx2; has_next = has2;
        if (wr == 1) G8_BAR;
    }
    G8_WAIT_V(0);
    G8_BAR;
#undef G8_SA
#undef G8_SB
#undef G8_STAGE
#undef G8_STAGEB
#undef G8_STAGEA
#undef G8_UNI
#undef G8_LDA
#undef G8_LDB
#undef G8_MMA
#undef G8_CAT
#undef G8_WAIT_V
#undef G8_WAIT_L
#undef G8_BAR
#undef G8_SCHED
}

struct StaticOrder {
    int nM, nN, nwg, G, c;
    __device__ void init(int nM_, int nN_, int G_, int c_) { nM = nM_; nN = nN_; nwg = nM * nN; G = G_; c = c_; }
    __device__ bool tile(int i, int& pm, int& pn) const {
        const long L = (long)i * G + c; if (L >= nwg) return false;
        int wgid = (int)L; { const int q = nwg / NXCD, r = nwg % NXCD, xcd = wgid % NXCD, off = wgid / NXCD; wgid = (xcd < r ? xcd * (q + 1) : r * (q + 1) + (xcd - r) * q) + off; }
        const int nig = 8 * nN, gid = wgid / nig, fm = gid * 8, gsz = (nM - fm) < 8 ? (nM - fm) : 8;
        pm = fm + ((wgid % nig) % gsz); pn = (wgid % nig) / gsz; return true;
    }
};
}
using g8::Unit;

struct Frame {
    LAS unsigned char* lds;
    unsigned* ctl;
    int wave, G, bx;
    int pw_done;
    unsigned char* ws;
    const float* const __attribute__((address_space(4)))* in;
    float* out;
};
enum { I_X = 0, I_P, I_RELB, I_NMIX, I_NFFN, I_AWIN, I_ALNG, I_ALNB, I_AWS, I_ABS, I_AWOUT, I_KVNORM, I_KVW, I_CMPPOS, I_CMPW1, I_CMPB1, I_CMPW2, I_KNORM,
       I_BWIN, I_BBGATE, I_QNORM, I_BWOUT, I_RW, I_RB, I_EWGU, I_EBGU, I_EWD, I_EBD, I_PLEW, I_PLEGW, I_PLENORM };

#define LDS_WAIT() asm volatile("s_waitcnt lgkmcnt(0)" ::: "memory")

struct ConvLd { f32x4 v[8]; };
__device__ __forceinline__ void conv_load(ConvLd& L, const float* W, int ldw, int ncols, int sc0, int kb, int lane) {
    const int k0 = 64 * kb, c4 = lane & 7, rr = lane >> 3; const bool ok = (sc0 + 4 * c4 + 3) < ncols;
#pragma unroll
    for (int i = 0; i < 8; ++i) L.v[i] = ok ? *(const f32x4*)(W + (size_t)(k0 + rr + 8 * i) * ldw + sc0 + 4 * c4) : (f32x4){0.f, 0.f, 0.f, 0.f};
}
template <bool F8> __device__ __forceinline__ void conv_store(const ConvLd& L, int K, const float* gain, bf16* WT, int db, int kb, LAS float* scr, int lane) {
    const int k0 = 64 * kb, c4 = lane & 7, rr = lane >> 3;
#pragma unroll
    for (int i = 0; i < 8; ++i) { const int kk = rr + 8 * i; const float gsc = gain ? gain[k0 + kk] : 1.0f; LAS float* p = scr + kk * 33 + 4 * c4;
        p[0] = L.v[i].x * gsc; p[1] = L.v[i].y * gsc; p[2] = L.v[i].z * gsc; p[3] = L.v[i].w * gsc; }
    LDS_WAIT(); asm volatile("" ::: "memory");
    const int c = lane & 7;
#pragma unroll
    for (int j = 0; j < 4; ++j) { const int rho = (lane >> 3) + 8 * j; const LAS float* s = scr + (8 * c) * 33 + g8::perm32(rho);
        if constexpr (F8) { u32x2 o; o.x = pk4_fp8(s[0 * 33] * F8_SW, s[1 * 33] * F8_SW, s[2 * 33] * F8_SW, s[3 * 33] * F8_SW); o.y = pk4_fp8(s[4 * 33] * F8_SW, s[5 * 33] * F8_SW, s[6 * 33] * F8_SW, s[7 * 33] * F8_SW);
            *(u32x2*)((unsigned char*)WT + (size_t)(32 * db + rho) * K + k0 + 8 * c) = o; }
        else { u32x4 o; o.x = pk2(s[0 * 33], s[1 * 33]); o.y = pk2(s[2 * 33], s[3 * 33]); o.z = pk2(s[4 * 33], s[5 * 33]); o.w = pk2(s[6 * 33], s[7 * 33]);
            *(u32x4*)(WT + (size_t)(32 * db + rho) * K + k0 + 8 * c) = o; } }
    LDS_WAIT(); asm volatile("" ::: "memory");
}
enum { MAP_ID = 0, MAP_HEAD = 1, MAP_GU = 2 };
template <int MAP> __device__ __forceinline__ int map_block(int db) {
    if (MAP == MAP_ID) return db;
    if (MAP == MAP_HEAD) { const int t = db >> 3, q = db & 7, bj = q >> 2, wc = q & 3; return t * 8 + 2 * wc + bj; }
    { const int pn = db >> 3, q = db & 7, bj = q >> 2, wc = q & 3; return bj * 32 + 4 * pn + wc; }
}
template <int MAP, bool F8 = false> __device__ __forceinline__ void conv_job(Frame& F, const float* W, size_t smat, int nmat, int K, int ldw, int ncols, int col0, const float* gain, int gstride, int gmat_div,
                                                          bf16* WT, size_t dmat, int ndb, LAS float* scr) {
    const int gw = F.bx * NWAVES + F.wave, NGW = F.G * NWAVES, lane = lane_id();
    const int nkb = K / 64, per = nkb * ndb, total = per * nmat;
    ConvLd q0, q1, q2, q3;
#define CV_LOAD(q, it_) do { const int _it = (it_); if (_it < total) { const int _m = _it / per, _r = _it % per; conv_load(q, W + (size_t)_m * smat, ldw, ncols, col0 + 32 * map_block<MAP>(_r % ndb), _r / ndb, lane); } } while (0)
#define CV_STORE(q, it_) do { const int _it = (it_); if (_it < total) { const int _m = _it / per, _r = _it % per; conv_store<F8>(q, K, gain ? gain + (size_t)(_m / gmat_div) * gstride : nullptr, WT + (size_t)_m * dmat, _r % ndb, _r / ndb, scr, lane); } } while (0)
    CV_LOAD(q0, gw); CV_LOAD(q1, gw + NGW); CV_LOAD(q2, gw + 2 * NGW);
    for (int it = gw; it < total; it += 4 * NGW) {
        CV_LOAD(q3, it + 3 * NGW); CV_STORE(q0, it);
        CV_LOAD(q0, it + 4 * NGW); CV_STORE(q1, it + NGW);
        CV_LOAD(q1, it + 5 * NGW); CV_STORE(q2, it + 2 * NGW);
        CV_LOAD(q2, it + 6 * NGW); CV_STORE(q3, it + 3 * NGW);
    }
#undef CV_LOAD
#undef CV_STORE
}
__device__ __forceinline__ void p0_prologue(Frame& F) {
    LAS float* scr = (LAS float*)(F.lds + LDS_STAGE + F.wave * 16384);
    unsigned char* ws = F.ws;
    const int gw = F.bx * NWAVES + F.wave, NGW = F.G * NWAVES;
    { const float* x = F.in[I_X]; bf16* hb = (bf16*)(ws + WS_HB0); float* ssq = (float*)(ws + WS_SSQ1);
      for (int m = gw; m < NTOK; m += NGW) {
          const f32x4* xr = (const f32x4*)(x + (size_t)m * D) + lane_id(); f32x4 v[4]; float s = 0.f;
#pragma unroll
          for (int j = 0; j < 4; ++j) { v[j] = xr[64 * j]; s += (v[j].x * v[j].x + v[j].y * v[j].y) + (v[j].z * v[j].z + v[j].w * v[j].w); }
          s = wave_sum(s);
          u32x2* o8 = (u32x2*)(hb + (size_t)m * D) + lane_id();
#pragma unroll
          for (int j = 0; j < 4; ++j) { u32x2 w; w.x = pk2(v[j].x, v[j].y); w.y = pk2(v[j].z, v[j].w); o8[64 * j] = w; }
          if (lane_id() == 0) ssq[m] = s;
      } }
    { unsigned long long* z = (unsigned long long*)(ws + WS_SSQ1 + 512 * 1024); for (int i = F.bx * NTHR + (F.wave * 64 + lane_id()); i < NTOK; i += F.G * NTHR) z[i] = 0ull; }
    { const f32x4* p = (const f32x4*)F.in[I_P]; u32x2* pb = (u32x2*)(ws + WS_PB); const size_t n4 = (size_t)2 * NTOK * PLE / 4;
      for (size_t i = (size_t)F.bx * NTHR + (F.wave * 64 + lane_id()); i < n4; i += (size_t)F.G * NTHR) { const f32x4 v = p[i]; u32x2 w; w.x = pk2(v.x, v.y); w.y = pk2(v.z, v.w); pb[i] = w; } }
    { const float* wsp = F.in[I_AWS]; bf16* o = (bf16*)(ws + WS_WAS);
      for (int i = F.bx * NTHR + (F.wave * 64 + lane_id()); i < 8 * 128 * 128; i += F.G * NTHR) { const int t = (i >> 7) & 127, s = i & 127; o[i] = (bf16)f2bf(s <= t ? wsp[i] : 0.f); } }
    { float* cb = (float*)(ws + WS_CB1);
      for (int o = 2 * F.bx + F.wave; F.wave < 2 && o < 2 * 256; o += 2 * F.G) { const int j = o >> 8, f = o & 255; const float* pos = F.in[I_CMPPOS] + (size_t)j * 2048 + lane_id(); const float* w1 = F.in[I_CMPW1] + (size_t)j * 2048 * 256 + f + (size_t)lane_id() * 256;
          float pv[32], wv[32];
#pragma unroll
          for (int i = 0; i < 32; ++i) { pv[i] = pos[64 * i]; wv[i] = w1[(size_t)64 * i * 256]; }
          float s = 0.f;
#pragma unroll
          for (int i = 0; i < 32; ++i) s += pv[i] * wv[i];
          s = wave_sum(s); if (lane_id() == 0) cb[o] = s + F.in[I_CMPB1][o]; } }
    conv_job<MAP_ID>(F, F.in[I_AWIN], 0, 1, D, 4096, 4096, 0, F.in[I_NMIX], 0, 1, (bf16*)(ws + WS_WAIN), 0, 128, scr);
    conv_job<MAP_ID>(F, F.in[I_AWOUT], 0, 1, GD, D, D, 0, nullptr, 0, 1, (bf16*)(ws + WS_WAOUT), 0, 32, scr);
    conv_job<MAP_HEAD, true>(F, F.in[I_KVW], 0, 1, D, 1536, 1536, 0, F.in[I_KVNORM], 0, 1, (bf16*)(ws + WS_WKVQ), 0, 48, scr);
    conv_job<MAP_HEAD, true>(F, F.in[I_BWIN], 0, 1, D, 1072, 1024, 0, F.in[I_NMIX] + D, 0, 1, (bf16*)(ws + WS_WKVQ + (size_t)1536 * D), 0, 32, scr);
    conv_job<MAP_ID, true>(F, F.in[I_BWIN], 0, 1, D, 1072, 1072, 1024, F.in[I_NMIX] + D, 0, 1, (bf16*)(ws + WS_WKVQ + (size_t)2560 * D), 0, 8, scr);
    conv_job<MAP_ID, true>(F, F.in[I_BWOUT], 0, 1, D, D, D, 0, nullptr, 0, 1, (bf16*)(ws + WS_WO), 0, 32, scr);
    conv_job<MAP_ID, true>(F, F.in[I_PLEGW], (size_t)D * D, 2, D, D, D, 0, F.in[I_PLENORM], D, 1, (bf16*)(ws + WS_WPG), (size_t)D * D / 2, 32, scr);
    conv_job<MAP_ID>(F, F.in[I_PLEW], (size_t)PLE * D, 2, PLE, D, D, 0, nullptr, 0, 1, (bf16*)(ws + WS_WPL), (size_t)D * PLE, 32, scr);
    conv_job<MAP_ID>(F, F.in[I_CMPW1], (size_t)2048 * 256, 2, 2048, 256, 256, 0, nullptr, 0, 1, (bf16*)(ws + WS_WC1), (size_t)256 * 2048, 8, scr);
    conv_job<MAP_GU, true>(F, F.in[I_EWGU], (size_t)D * 2048, 32, D, 2048, 2048, 0, F.in[I_NFFN], D, 32, (bf16*)(ws + WS_WGU), (size_t)2048 * D / 2, 64, scr);
    conv_job<MAP_ID, true>(F, F.in[I_EWD], (size_t)D * D, 32, D, D, D, 0, nullptr, 0, 1, (bf16*)(ws + WS_WD), (size_t)D * D / 2, 32, scr);
}

__device__ __forceinline__ void conv_l1_slice(Frame& F, const int k, LAS float* scr) {
    const int gw = F.bx * NWAVES + F.wave, NGW = F.G * NWAVES, lane = lane_id();
    const int dit = k * NGW + gw; if (dit >= 16384) return;
    unsigned char* ws = F.ws;
    const float* Wg = F.in[I_EWGU] + (size_t)32 * D * 2048; const float* Wd = F.in[I_EWD] + (size_t)32 * D * D; const float* gain = F.in[I_NFFN] + D;
    bf16* Tg = (bf16*)(ws + WS_WGU) + (size_t)32 * (2048 * D / 2); bf16* Td = (bf16*)(ws + WS_WD) + (size_t)32 * (D * D / 2);
    ConvLd q0, q1, q2;
    const int g0 = 2 * dit, g1 = g0 + 1, m0 = g0 >> 10, r0 = g0 & 1023, m1 = g1 >> 10, r1 = g1 & 1023, md = dit >> 9, rd = dit & 511;
    conv_load(q0, Wg + (size_t)m0 * D * 2048, 2048, 2048, 32 * map_block<MAP_GU>(r0 & 63), r0 >> 6, lane);
    conv_load(q1, Wg + (size_t)m1 * D * 2048, 2048, 2048, 32 * map_block<MAP_GU>(r1 & 63), r1 >> 6, lane);
    conv_load(q2, Wd + (size_t)md * D * D, D, D, 32 * map_block<MAP_ID>(rd & 31), rd >> 5, lane);
    conv_store<true>(q0, D, gain, Tg + (size_t)m0 * (2048 * D / 2), r0 & 63, r0 >> 6, scr, lane);
    conv_store<true>(q1, D, gain, Tg + (size_t)m1 * (2048 * D / 2), r1 & 63, r1 >> 6, scr, lane);
    conv_store<true>(q2, D, nullptr, Td + (size_t)md * (D * D / 2), rd & 31, rd >> 5, scr, lane);
}

struct SchedPlain {
    g8::StaticOrder so; const bf16* A; const bf16* Bt; int lda, K;
    __device__ __forceinline__ bool next(int i, Unit& u) const { u.e = 0; u.pos0 = 0; u.cnt = 0; return so.tile(i, u.pm, u.pn); }
    __device__ __forceinline__ const char* a_ptr(const Unit& u) const { return (const char*)(A + (size_t)u.pm * 256 * lda); }
    __device__ __forceinline__ const char* b_ptr(const Unit& u) const { return (const char*)(Bt + (size_t)u.pn * 256 * K); }
    __device__ __forceinline__ int row_off(const Unit&, int) const { return 0; }
};
struct SchedPair {
    g8::StaticOrder so; const bf16* A0; const bf16* A1; const bf16* B0; const bf16* B1; int lda, K, nMh;
    __device__ __forceinline__ bool next(int i, Unit& u) const { u.pos0 = 0; u.cnt = 0; const bool ok = so.tile(i, u.pm, u.pn); u.e = ok ? (u.pm >= nMh ? 1 : 0) : 0; return ok; }
    __device__ __forceinline__ const char* a_ptr(const Unit& u) const { return (const char*)((u.e ? A1 : A0) + (size_t)(u.pm - u.e * nMh) * 256 * lda); }
    __device__ __forceinline__ const char* b_ptr(const Unit& u) const { return (const char*)((u.e ? B1 : B0) + (size_t)u.pn * 256 * K); }
    __device__ __forceinline__ int row_off(const Unit&, int) const { return 0; }
};
struct SchedPw {
    int first, stride, count, limit; const bf16* A0; const bf16* B0;
    __device__ __forceinline__ bool next(int i, Unit& u) const { u.pos0 = 0; u.cnt = 0; const int t = first + i * stride; const bool ok = i < count && t < limit; u.pm = ok ? t >> 2 : 0; u.pn = ok ? t & 3 : 0; u.e = u.pm >= NTOK / 256 ? 1 : 0; return ok; }
    __device__ __forceinline__ const char* a_ptr(const Unit& u) const { return (const char*)(A0 + (size_t)u.pm * 256 * PLE); }
    __device__ __forceinline__ const char* b_ptr(const Unit& u) const { return (const char*)(B0 + ((size_t)u.e * D + (size_t)u.pn * 256) * PLE); }
    __device__ __forceinline__ int row_off(const Unit&, int) const { return 0; }
};
struct MoeTab { LAS int* tile_e; LAS int* tile0; LAS int* cnt; int ntile; };
__device__ __forceinline__ MoeTab moe_build_tab(Frame& F, int layer) {
    MoeTab T; T.tile_e = (LAS int*)(F.lds + LDS_AUX); T.tile0 = T.tile_e + 640; T.cnt = T.tile0 + 64;
    LAS int* ntile = T.cnt + 64;
    __syncthreads();
    if ((F.wave * 64 + lane_id()) < 32) T.cnt[(F.wave * 64 + lane_id())] = (int)__hip_atomic_load(F.ctl + CW_CNT + (layer * 32 + (F.wave * 64 + lane_id())) * 64, __ATOMIC_RELAXED, __HIP_MEMORY_SCOPE_AGENT);
    __syncthreads();
    if ((F.wave * 64 + lane_id()) == 0) { int t = 0; for (int e = 0; e < 32; ++e) { T.tile0[e] = t; t += (T.cnt[e] + 255) >> 8; } T.tile0[32] = t; *ntile = t; }
    __syncthreads();
    for (int t = F.wave * 64 + lane_id(); t < *ntile; t += NTHR) { int e = 0;
#pragma unroll
        for (int k = 1; k < 32; ++k) e += (T.tile0[k] <= t) ? 1 : 0;
        T.tile_e[t] = e; }
    __syncthreads();
    T.ntile = __builtin_amdgcn_readfirstlane(*ntile);
    return T;
}
template <int NN, int GM>
struct SchedMoe {
    MoeTab T; int G, c, nU; const char* A; const char* W; const int* lslot; int gather; size_t wstride; int rowb;
    __device__ __forceinline__ void init(const MoeTab& T_, int G_, int c_) { T = T_; G = G_; c = c_; nU = T.ntile * NN; }
    __device__ __forceinline__ bool next(int i, Unit& u) const {
        const long L = (long)i * G + c; if (L >= nU) return false;
        int w = (int)L; { const int q = nU / 8, r = nU % 8, xcd = w % 8, off = w / 8; w = (xcd < r ? xcd * (q + 1) : r * (q + 1) + (xcd - r) * q) + off; }
        const int gsz = GM * NN, gid = w / gsz, fm = gid * GM, rem = T.ntile - fm, gm = rem < GM ? rem : GM, r2 = w % gsz;
        u.pm = fm + r2 % gm; u.pn = r2 / gm;
        const int e = __builtin_amdgcn_readfirstlane(T.tile_e[u.pm]); u.e = e; u.pos0 = (u.pm - __builtin_amdgcn_readfirstlane(T.tile0[e])) * 256; u.cnt = __builtin_amdgcn_readfirstlane(T.cnt[e]);
        return true;
    }
    __device__ __forceinline__ const char* a_ptr(const Unit& u) const { return gather ? A : A + (size_t)u.pm * 256 * rowb; }
    __device__ __forceinline__ const char* b_ptr(const Unit& u) const { return W + (size_t)u.e * wstride + (size_t)u.pn * 256 * rowb; }
    __device__ __forceinline__ int row_off(const Unit& u, int r) const { int pos = u.pos0 + r; pos = pos < u.cnt ? pos : u.cnt - 1; return (lslot[(size_t)u.e * NTOK + pos] >> 2) * rowb; }
};

#define EPI_ROWS(ai, m) (128 * (ai) + 64 * wr + 16 * (m) + fr)
#define EPI_COL(bj) (128 * (bj) + 32 * wc + 8 * fq)
__device__ __forceinline__ u32x4 pack8(const f32x4& a, const f32x4& b) { u32x4 w; w.x = pk2(a.x, a.y); w.y = pk2(a.z, a.w); w.z = pk2(b.x, b.y); w.w = pk2(b.z, b.w); return w; }
__device__ __forceinline__ float sq4(const f32x4& a) { return (a.x * a.x + a.y * a.y) + (a.z * a.z + a.w * a.w); }
__device__ __forceinline__ float sum4(const f32x4& a) { return (a.x + a.y) + (a.z + a.w); }

struct EpiGelu {
    bf16* U; bf16* V; const float* ssq; float* lnp;
    __device__ __forceinline__ void operator()(const f32x4 (&acc)[2][2][4][2], const Unit& u, int wr, int wc, int fr, int fq) const {
        const bool isv = u.pn >= 8; bf16* base = isv ? V : U; const int ct = (isv ? u.pn - 8 : u.pn) * 256;
        float rsv[2][4];
#pragma unroll
        for (int ai = 0; ai < 2; ++ai)
#pragma unroll
            for (int m = 0; m < 4; ++m) rsv[ai][m] = ssq[u.pm * 256 + EPI_ROWS(ai, m)];
#pragma unroll
        for (int ai = 0; ai < 2; ++ai)
#pragma unroll
            for (int m = 0; m < 4; ++m) { const int row = u.pm * 256 + EPI_ROWS(ai, m); const float rs = rstd_of(rsv[ai][m]); float s1 = 0.f, s2 = 0.f;
#pragma unroll
                for (int bj = 0; bj < 2; ++bj) { f32x4 v0 = acc[ai][bj][m][0] * rs, v1 = acc[ai][bj][m][1] * rs;
                    { const f32x2 a = gelu_tanh2((f32x2){v0.x, v0.y}), b = gelu_tanh2((f32x2){v0.z, v0.w}), c = gelu_tanh2((f32x2){v1.x, v1.y}), d = gelu_tanh2((f32x2){v1.z, v1.w});
                      v0 = (f32x4){a.x, a.y, b.x, b.y}; v1 = (f32x4){c.x, c.y, d.x, d.y}; }
                    *(u32x4*)(base + (size_t)row * GD + ct + EPI_COL(bj)) = pack8(v0, v1);
                    s1 += sum4(v0) + sum4(v1); s2 += sq4(v0) + sq4(v1); }
                if (isv) { s1 = xsum32(xsum16(s1)); s2 = xsum32(xsum16(s2));
                    if (fq == 0) *(f32x2*)(lnp + ((size_t)row * 32 + (u.pn - 8) * 4 + wc) * 2) = (f32x2){s1, s2}; } }
    }
};
template <bool BASE16> struct EpiResid {
    const void* base; bf16* hf; unsigned char* hq; float sc;
    __device__ __forceinline__ void operator()(const f32x4 (&acc)[2][2][4][2], const Unit& u, int wr, int wc, int fr, int fq) const {
#pragma unroll
        for (int ai = 0; ai < 2; ++ai) {
            f32x4 pre[4][2][2];
#pragma unroll
            for (int m = 0; m < 4; ++m)
#pragma unroll
                for (int bj = 0; bj < 2; ++bj) { const size_t o = (size_t)(u.pm * 256 + EPI_ROWS(ai, m)) * D + u.pn * 256 + EPI_COL(bj);
                    if constexpr (BASE16) { const u32x4 w = *(const u32x4*)((const bf16*)base + o); pre[m][bj][0] = (f32x4){bflo(w.x), bfhi(w.x), bflo(w.y), bfhi(w.y)}; pre[m][bj][1] = (f32x4){bflo(w.z), bfhi(w.z), bflo(w.w), bfhi(w.w)}; }
                    else { pre[m][bj][0] = *(const f32x4*)((const float*)base + o); pre[m][bj][1] = *(const f32x4*)((const float*)base + o + 4); } }
#pragma unroll
            for (int m = 0; m < 4; ++m)
#pragma unroll
                for (int bj = 0; bj < 2; ++bj) { const size_t o = (size_t)(u.pm * 256 + EPI_ROWS(ai, m)) * D + u.pn * 256 + EPI_COL(bj);
                    const f32x4 h0 = pre[m][bj][0] + acc[ai][bj][m][0] * sc, h1 = pre[m][bj][1] + acc[ai][bj][m][1] * sc;
                    *(u32x4*)(hf + o) = pack8(h0, h1);
                    const f32x4 q0 = h0 * F8_SA, q1 = h1 * F8_SA; *(u32x2*)(hq + o) = (u32x2){pk4_fp8(q0.x, q0.y, q0.z, q0.w), pk4_fp8(q1.x, q1.y, q1.z, q1.w)}; }
        }
    }
};
struct EpiPw {
    bf16* pw;
    __device__ __forceinline__ void operator()(const f32x4 (&acc)[2][2][4][2], const Unit& u, int wr, int wc, int fr, int fq) const {
#pragma unroll
        for (int ai = 0; ai < 2; ++ai)
#pragma unroll
            for (int m = 0; m < 4; ++m) { const int row = u.pm * 256 + EPI_ROWS(ai, m);
#pragma unroll
                for (int bj = 0; bj < 2; ++bj) *(u32x4*)(pw + (size_t)row * D + u.pn * 256 + EPI_COL(bj)) = pack8(acc[ai][bj][m][0], acc[ai][bj][m][1]); }
    }
};
template <bool FINAL> struct EpiPle {
    bf16* hr; const bf16* pw; const float* ssq1; unsigned char* hq; unsigned long long* ssq_out; float* out;
    __device__ __forceinline__ void operator()(const f32x4 (&acc)[2][2][4][2], const Unit& u, int wr, int wc, int fr, int fq) const {
        float rsv[2][4];
#pragma unroll
        for (int ai = 0; ai < 2; ++ai)
#pragma unroll
            for (int m = 0; m < 4; ++m) rsv[ai][m] = ssq1[u.pm * 256 + EPI_ROWS(ai, m)];
#pragma unroll
        for (int ai = 0; ai < 2; ++ai)
#pragma unroll
            for (int mp = 0; mp < 2; ++mp) {
            u32x4 ph[2][2], pp[2][2];
#pragma unroll
            for (int mm = 0; mm < 2; ++mm)
#pragma unroll
                for (int bj = 0; bj < 2; ++bj) { const size_t o = (size_t)(u.pm * 256 + EPI_ROWS(ai, 2 * mp + mm)) * D + u.pn * 256 + EPI_COL(bj); ph[mm][bj] = *(const u32x4*)(hr + o); pp[mm][bj] = *(const u32x4*)(pw + o); }
#pragma unroll
            for (int mm = 0; mm < 2; ++mm) { const int m = 2 * mp + mm, row = u.pm * 256 + EPI_ROWS(ai, m); const float rs = rstd_of(rsv[ai][m]) * (1.0f / (F8_SA * F8_SW)); float ss = 0.f;
#pragma unroll
                for (int bj = 0; bj < 2; ++bj) { const size_t o = (size_t)row * D + u.pn * 256 + EPI_COL(bj);
                    const u32x4 pv = pp[mm][bj], hv = ph[mm][bj]; f32x4 h0 = {bflo(hv.x), bfhi(hv.x), bflo(hv.y), bfhi(hv.y)}, h1 = {bflo(hv.z), bfhi(hv.z), bflo(hv.w), bfhi(hv.w)};
                    const f32x4 g0 = acc[ai][bj][m][0] * rs, g1 = acc[ai][bj][m][1] * rs;
                    h0.x += bflo(pv.x) * sigmoidf_(g0.x); h0.y += bfhi(pv.x) * sigmoidf_(g0.y); h0.z += bflo(pv.y) * sigmoidf_(g0.z); h0.w += bfhi(pv.y) * sigmoidf_(g0.w);
                    h1.x += bflo(pv.z) * sigmoidf_(g1.x); h1.y += bfhi(pv.z) * sigmoidf_(g1.y); h1.z += bflo(pv.w) * sigmoidf_(g1.z); h1.w += bfhi(pv.w) * sigmoidf_(g1.w);
                    if (FINAL) { *(f32x4*)(out + o) = h0; *(f32x4*)(out + o + 4) = h1; }
                    else { *(u32x4*)(hr + o) = pack8(h0, h1); const f32x4 q0 = h0 * F8_SA, q1 = h1 * F8_SA; *(u32x2*)(hq + o) = (u32x2){pk4_fp8(q0.x, q0.y, q0.z, q0.w), pk4_fp8(q1.x, q1.y, q1.z, q1.w)}; ss += sq4(h0) + sq4(h1); } }
                if (!FINAL) { ss = xsum32(xsum16(ss)); if (fq == 0) atomicAdd(ssq_out + row, (unsigned long long)(ss * 1048576.0f)); } }
        }
    }
};
struct EpiMoe1 {
    unsigned char* act; const float* bgu; const float* lrs;
    __device__ __forceinline__ void operator()(const f32x4 (&acc)[2][2][4][2], const Unit& u, int wr, int wc, int fr, int fq) const {
        const int j0 = u.pn * 128 + 32 * wc + 8 * fq; const float* bg = bgu + (size_t)u.e * 2048 + j0;
        float rsv[2][4];
#pragma unroll
        for (int ai = 0; ai < 2; ++ai)
#pragma unroll
            for (int m = 0; m < 4; ++m) { int pos = u.pos0 + EPI_ROWS(ai, m); pos = pos < u.cnt ? pos : u.cnt - 1; rsv[ai][m] = lrs[(size_t)u.e * NTOK + pos] * (1.0f / (F8_SA * F8_SW)); }
        const f32x4 bg0 = *(const f32x4*)bg, bg1 = *(const f32x4*)(bg + 4), bu0 = *(const f32x4*)(bg + 1024), bu1 = *(const f32x4*)(bg + 1028);
        const int odd = fq & 1;
#pragma unroll
        for (int ai = 0; ai < 2; ++ai)
#pragma unroll
            for (int mp = 0; mp < 2; ++mp) { u32x2 pk[2];
#pragma unroll
                for (int mm = 0; mm < 2; ++mm) { const int m = 2 * mp + mm; const f32x2 rs = {rsv[ai][m], rsv[ai][m]};
                    f32x2 a[4];
#pragma unroll
                    for (int p = 0; p < 4; ++p) { const f32x4 cg = acc[ai][0][m][p >> 1], cu = acc[ai][1][m][p >> 1], vbg = (p >> 1) ? bg1 : bg0, vbu = (p >> 1) ? bu1 : bu0;
                        const f32x2 ag = (p & 1) ? (f32x2){cg.z, cg.w} : (f32x2){cg.x, cg.y}, au = (p & 1) ? (f32x2){cu.z, cu.w} : (f32x2){cu.x, cu.y};
                        const f32x2 pbg = (p & 1) ? (f32x2){vbg.z, vbg.w} : (f32x2){vbg.x, vbg.y}, pbu = (p & 1) ? (f32x2){vbu.z, vbu.w} : (f32x2){vbu.x, vbu.y};
                        f32x2 g = __builtin_elementwise_fma(ag, rs, pbg), up = __builtin_elementwise_fma(au, rs, pbu);
                        g.x = fminf(g.x, 7.0f); g.y = fminf(g.y, 7.0f); up.x = __builtin_amdgcn_fmed3f(up.x, -7.0f, 7.0f); up.y = __builtin_amdgcn_fmed3f(up.y, -7.0f, 7.0f);
                        const f32x2 t = g * (f32x2){-1.702f * 1.44269504089f, -1.702f * 1.44269504089f};
                        const f32x2 d = (f32x2){fast_exp2(t.x), fast_exp2(t.y)} + (f32x2){1.0f, 1.0f};
                        const f32x2 rr = {fast_rcp(d.x), fast_rcp(d.y)};
                        a[p] = __builtin_elementwise_fma(up, (f32x2){F8_SACT, F8_SACT}, (f32x2){F8_SACT, F8_SACT}) * (g * rr); }
                    pk[mm] = (u32x2){pk4_fp8(a[0].x, a[0].y, a[1].x, a[1].y), pk4_fp8(a[2].x, a[2].y, a[3].x, a[3].y)}; }
                unsigned x0 = pk[0].x, x1 = pk[0].y, y0 = pk[1].x, y1 = pk[1].y; swap16(x0, y0); swap16(x1, y1);
                *(u32x4*)(act + (size_t)(u.pm * 256 + EPI_ROWS(ai, 2 * mp) + 16 * odd) * D + j0 - 8 * odd) = (u32x4){x0, x1, y0, y1}; }
    }
};
struct EpiMoe2 {
    unsigned char* y; const float* bd; const int* lslot; const float* lw; unsigned char* trash;
    __device__ __forceinline__ void operator()(const f32x4 (&acc)[2][2][4][2], const Unit& u, int wr, int wc, int fr, int fq) const {
        f32x4 b[2][2];
#pragma unroll
        for (int bj = 0; bj < 2; ++bj) { const float* bp = bd + (size_t)u.e * D + u.pn * 256 + EPI_COL(bj); b[bj][0] = *(const f32x4*)bp; b[bj][1] = *(const f32x4*)(bp + 4); }
        int slv[2][4]; float wv[2][4];
#pragma unroll
        for (int ai = 0; ai < 2; ++ai)
#pragma unroll
            for (int m = 0; m < 4; ++m) { int pos = u.pos0 + EPI_ROWS(ai, m); pos = pos < u.cnt ? pos : u.cnt - 1; slv[ai][m] = lslot[(size_t)u.e * NTOK + pos]; wv[ai][m] = lw[(size_t)u.e * NTOK + pos]; }
        const int odd = fq & 1;
#pragma unroll
        for (int ai = 0; ai < 2; ++ai)
#pragma unroll
            for (int mp = 0; mp < 2; ++mp) { const int m0 = 2 * mp, m1 = m0 + 1;
                const bool ok0 = (u.pos0 + EPI_ROWS(ai, m0)) < u.cnt, ok1 = (u.pos0 + EPI_ROWS(ai, m1)) < u.cnt;
                unsigned char* rp0 = ok0 ? y + (size_t)slv[ai][m0] * D + u.pn * 256 : trash; unsigned char* rp1 = ok1 ? y + (size_t)slv[ai][m1] * D + u.pn * 256 : trash;
                unsigned char* rp = (odd ? rp1 : rp0) - 8 * odd;
                const float ws0 = wv[ai][m0] * F8_SY, ws1 = wv[ai][m1] * F8_SY;
#pragma unroll
                for (int bj = 0; bj < 2; ++bj) {
                    const f32x4 x0 = (acc[ai][bj][m0][0] * (1.0f / (F8_SACT * F8_SW)) + b[bj][0]) * ws0, x1 = (acc[ai][bj][m0][1] * (1.0f / (F8_SACT * F8_SW)) + b[bj][1]) * ws0;
                    const f32x4 y0 = (acc[ai][bj][m1][0] * (1.0f / (F8_SACT * F8_SW)) + b[bj][0]) * ws1, y1 = (acc[ai][bj][m1][1] * (1.0f / (F8_SACT * F8_SW)) + b[bj][1]) * ws1;
                    unsigned Xa = pk4_fp8(x0.x, x0.y, x0.z, x0.w), Xb = pk4_fp8(x1.x, x1.y, x1.z, x1.w), Ya = pk4_fp8(y0.x, y0.y, y0.z, y0.w), Yb = pk4_fp8(y1.x, y1.y, y1.z, y1.w);
                    swap16(Xa, Ya); swap16(Xb, Yb);
                    *(u32x4*)(rp + EPI_COL(bj)) = (u32x4){Xa, Xb, Ya, Yb}; } }
    }
};
struct EpiKvq {
    const unsigned long long* ssq;   bf16 *kc, *vc, *ksel, *vsel, *kwin, *vwin; bf16* q; float* gates; const float* knorm; const float* qnorm; const float* bgate;
    __device__ __forceinline__ void operator()(const f32x4 (&acc)[2][2][4][2], const Unit& u, int wr, int wc, int fr, int fq) const {
        const int pn = u.pn;
        if (pn == 10) {
            if (wc < 2) {
                float bgv[2][4]; unsigned long long rg[2][4];
#pragma unroll
                for (int n = 0; n < 2; ++n)
#pragma unroll
                    for (int j = 0; j < 4; ++j) { const int c = 32 * wc + 8 * fq + 4 * n + j; bgv[n][j] = bgate[c < 48 ? c : 47]; }
#pragma unroll
                for (int ai = 0; ai < 2; ++ai)
#pragma unroll
                    for (int m = 0; m < 4; ++m) rg[ai][m] = ssq[u.pm * 256 + EPI_ROWS(ai, m)];
#pragma unroll
                for (int ai = 0; ai < 2; ++ai)
#pragma unroll
                    for (int m = 0; m < 4; ++m) { const int row = u.pm * 256 + EPI_ROWS(ai, m); const float rs = rstd_of((float)rg[ai][m] * (1.0f / 1048576.0f)) * (1.0f / (F8_SA * F8_SW));
#pragma unroll
                        for (int n = 0; n < 2; ++n) { const int c0 = 32 * wc + 8 * fq + 4 * n;
                            if (c0 < 48) { f32x4 gv;
#pragma unroll
                                for (int j = 0; j < 4; ++j) gv[j] = sigmoidf_(acc[ai][0][m][n][j] * rs + bgv[n][j]);
                                *(f32x4*)(gates + (size_t)row * 48 + c0) = gv; } } }
            }
            return;
        }
        const bool isq = pn >= 6, normed = isq || pn == 2 || pn == 4;
        const float* gn = isq ? qnorm : knorm + (pn == 2 ? 64 : 128);
        f32x4 gv[2][2];
#pragma unroll
        for (int bj = 0; bj < 2; ++bj) { gv[bj][0] = *(const f32x4*)(gn + 32 * bj + 8 * fq); gv[bj][1] = *(const f32x4*)(gn + 32 * bj + 8 * fq + 4); }
        const float post = isq ? 0.125f : 1.0f;
        float rsf[2][4];
        { unsigned long long rsv[2][4];
#pragma unroll
          for (int ai = 0; ai < 2; ++ai)
#pragma unroll
              for (int m = 0; m < 4; ++m) rsv[ai][m] = ssq[u.pm * 256 + EPI_ROWS(ai, m)];
#pragma unroll
          for (int ai = 0; ai < 2; ++ai)
#pragma unroll
              for (int m = 0; m < 4; ++m) rsf[ai][m] = rstd_of((float)rsv[ai][m] * (1.0f / 1048576.0f)) * (1.0f / (F8_SA * F8_SW)); }
#pragma unroll
        for (int ai = 0; ai < 2; ++ai)
#pragma unroll
            for (int m = 0; m < 4; ++m) { const int row = u.pm * 256 + EPI_ROWS(ai, m); const float rs = rsf[ai][m];
                f32x4 v[2][2]; float ss = 0.f;
#pragma unroll
                for (int bj = 0; bj < 2; ++bj) { v[bj][0] = acc[ai][bj][m][0] * rs; v[bj][1] = acc[ai][bj][m][1] * rs; ss += sq4(v[bj][0]) + sq4(v[bj][1]); }
                if (normed) { ss = xsum32(xsum16(ss)); const float r2 = __builtin_amdgcn_rsqf(ss * (1.0f / 64.0f) + EPS) * post;
#pragma unroll
                    for (int bj = 0; bj < 2; ++bj) { v[bj][0] = v[bj][0] * gv[bj][0] * r2; v[bj][1] = v[bj][1] * gv[bj][1] * r2; } }
                if (pn == 3 || pn == 5) {
                    const int b = row >> 13, s0 = row & 8191, s = (s0 & ~12) | ((s0 & 4) << 1) | ((s0 & 8) >> 1); bf16* vt = (pn == 3 ? vsel : vwin) + ((size_t)(b * 4 + wc) * 64 + 8 * fq) * SEQ + s;
#pragma unroll
                    for (int bj = 0; bj < 2; ++bj)
#pragma unroll
                        for (int n = 0; n < 2; ++n)
#pragma unroll
                            for (int j = 0; j < 4; ++j) vt[(size_t)(32 * bj + 4 * n + j) * SEQ] = (bf16)f2bf(v[bj][n][j]);
                } else {
                bf16* dst;
                if (isq) dst = q + (size_t)row * D + ((pn - 6) * 4 + wc) * 64;
                else { const int b = row >> 13, s = row & 8191; bf16* kvb = pn == 0 ? kc : pn == 1 ? vc : pn == 2 ? ksel : kwin; dst = kvb + ((size_t)(b * 4 + wc) * SEQ + s) * 64; }
#pragma unroll
                for (int bj = 0; bj < 2; ++bj) *(u32x4*)(dst + 32 * bj + 8 * fq) = pack8(v[bj][0], v[bj][1]); } }
    }
};
struct EpiGates {
    const unsigned long long* ssq; float* gates; const float* bgate;
    __device__ __forceinline__ void operator()(const f32x4 (&acc)[2][2][4][2], const Unit& u, int wr, int wc, int fr, int fq) const {
        if (wc >= 2) return;
        float bgv[2][4]; unsigned long long rg[2][4];
#pragma unroll
        for (int n = 0; n < 2; ++n)
#pragma unroll
            for (int j = 0; j < 4; ++j) { const int c = 32 * wc + 8 * fq + 4 * n + j; bgv[n][j] = bgate[c < 48 ? c : 47]; }
#pragma unroll
        for (int ai = 0; ai < 2; ++ai)
#pragma unroll
            for (int m = 0; m < 4; ++m) rg[ai][m] = ssq[u.pm * 256 + EPI_ROWS(ai, m)];
#pragma unroll
        for (int ai = 0; ai < 2; ++ai)
#pragma unroll
            for (int m = 0; m < 4; ++m) { const int row = u.pm * 256 + EPI_ROWS(ai, m); const float rs = rstd_of((float)rg[ai][m] * (1.0f / 1048576.0f)) * (1.0f / (F8_SA * F8_SW));
#pragma unroll
                for (int n = 0; n < 2; ++n) { const int c0 = 32 * wc + 8 * fq + 4 * n;
                    if (c0 < 48) { f32x4 gv;
#pragma unroll
                        for (int j = 0; j < 4; ++j) gv[j] = sigmoidf_(acc[ai][0][m][n][j] * rs + bgv[n][j]);
                        *(f32x4*)(gates + (size_t)row * 48 + c0) = gv; } } }
    }
};
struct EpiCmp {
    bf16* hid; const float* cb1; int nMh;
    __device__ __forceinline__ void operator()(const f32x4 (&acc)[2][2][4][2], const Unit& u, int wr, int wc, int fr, int fq) const {
        f32x4 b[2][2];
#pragma unroll
        for (int bj = 0; bj < 2; ++bj) { const float* bp = cb1 + u.e * 256 + EPI_COL(bj); b[bj][0] = *(const f32x4*)bp; b[bj][1] = *(const f32x4*)(bp + 4); }
#pragma unroll
        for (int ai = 0; ai < 2; ++ai)
#pragma unroll
            for (int m = 0; m < 4; ++m) { const int row = (u.pm - u.e * nMh) * 256 + EPI_ROWS(ai, m);
#pragma unroll
                for (int bj = 0; bj < 2; ++bj) { f32x4 v0 = acc[ai][bj][m][0] + b[bj][0], v1 = acc[ai][bj][m][1] + b[bj][1];
#pragma unroll
                    for (int j = 0; j < 4; ++j) { v0[j] = gelu_tanh(v0[j]); v1[j] = gelu_tanh(v1[j]); }
                    *(u32x4*)(hid + ((size_t)u.e * 8192 + row) * 256 + EPI_COL(bj)) = pack8(v0, v1); } }
    }
};

__device__ __forceinline__ void p2_spatial(Frame& F) {
    unsigned char* ws = F.ws;
    bf16* U = (bf16*)(ws + WS_U); const bf16* V = (const bf16*)(ws + WS_V); const float* lnp = (const float*)(ws + WS_LNP); const bf16* WAS = (const bf16*)(ws + WS_WAS);
    const float* lng = F.in[I_ALNG]; const float* lnb = F.in[I_ALNB]; const float* bs = F.in[I_ABS];
    LAS bf16* vt = (LAS bf16*)F.lds;
    LAS float* st = (LAS float*)(F.lds + 256 * 272);
    const int tid = (F.wave * 64 + lane_id()), lane = lane_id(), w = F.wave, r32 = lane & 31, h = lane >> 5, dp = w & 3, tp = w >> 2;
    bf16x8 bw[8][2]; int gl = -1;
#pragma unroll
    for (int ks = 0; ks < 8; ++ks) { bw[ks][0] = (bf16x8){0, 0, 0, 0, 0, 0, 0, 0}; bw[ks][1] = bw[ks][0]; }
    for (int unit = F.bx; unit < 2048; unit += F.G) {
        const int c = unit >> 3, g = unit & 7, row0 = c * 128;
        if (g != gl) {
#pragma unroll
            for (int ks = 0; ks < 8; ++ks)
#pragma unroll
                for (int x = 0; x < 2; ++x) bw[ks][x] = (ks < 4 * tp + 4) ? *(const bf16x8*)(WAS + ((size_t)(g * 128 + 32 * (2 * tp + x) + r32)) * 128 + 16 * ks + 8 * h) : bw[ks][x];
            gl = g; }
        __syncthreads();
        if (tid < 128) { const f32x4* p = (const f32x4*)(lnp + (size_t)(row0 + tid) * 64); float s1 = 0.f, s2 = 0.f;
#pragma unroll
            for (int k = 0; k < 16; ++k) { const f32x4 v = p[k]; s1 += v.x + v.z; s2 += v.y + v.w; }
            const float mu = s1 * (1.0f / GD), var = s2 * (1.0f / GD) - mu * mu; st[tid * 2] = mu; st[tid * 2 + 1] = __builtin_amdgcn_rsqf(fmaxf(var, 0.f) + EPS); }
        __syncthreads();
        { LAS unsigned char* stg = F.lds + 70656 + w * 9216;
#pragma unroll
          for (int it = 0; it < 8; ++it) { const int rr = 2 * it + (lane >> 5), ch = lane & 31;
              *(LAS u32x4*)(stg + rr * 528 + ch * 16) = *(const u32x4*)(V + (size_t)(row0 + 16 * w + rr) * GD + g * 256 + ch * 8); }
          LDS_WAIT(); asm volatile("" ::: "memory");
          const int sl = lane & 15, s = 16 * w + sl; const float mu = st[s * 2], rs = st[s * 2 + 1];
#pragma unroll 2
          for (int it = 0; it < 8; ++it) { const int ch = (lane >> 4) + 4 * it, d0 = ch * 8; const u32x4 raw = *(const LAS u32x4*)(stg + sl * 528 + ch * 16);
              const f32x4 g0 = *(const f32x4*)(lng + g * 256 + d0), g1 = *(const f32x4*)(lng + g * 256 + d0 + 4), b0 = *(const f32x4*)(lnb + g * 256 + d0), b1 = *(const f32x4*)(lnb + g * 256 + d0 + 4);
              const unsigned rw[4] = {raw.x, raw.y, raw.z, raw.w};
#pragma unroll
              for (int j = 0; j < 4; ++j) { const float ga = j < 2 ? g0[2 * j] : g1[2 * j - 4], gb = j < 2 ? g0[2 * j + 1] : g1[2 * j - 3], ba = j < 2 ? b0[2 * j] : b1[2 * j - 4], bb = j < 2 ? b0[2 * j + 1] : b1[2 * j - 3];
                  vt[(d0 + 2 * j) * 136 + s] = (bf16)f2bf((bflo(rw[j]) - mu) * rs * ga + ba); vt[(d0 + 2 * j + 1) * 136 + s] = (bf16)f2bf((bfhi(rw[j]) - mu) * rs * gb + bb); } }
          LDS_WAIT(); asm volatile("" ::: "memory"); }
        __syncthreads();
        f32x16 acc[2][2];
#pragma unroll
        for (int a = 0; a < 2; ++a)
#pragma unroll
            for (int b = 0; b < 2; ++b)
#pragma unroll
                for (int k = 0; k < 16; ++k) acc[a][b][k] = 0.f;
#pragma unroll
        for (int ks = 0; ks < 8; ++ks) {
            if (ks < 4 * tp + 4) {
                bf16x8 a[2];
#pragma unroll
                for (int x = 0; x < 2; ++x) a[x] = *(const LAS bf16x8*)(vt + (32 * (2 * dp + x) + r32) * 136 + 16 * ks + 8 * h);
#pragma unroll
                for (int x = 0; x < 2; ++x)
#pragma unroll
                    for (int y = 0; y < 2; ++y) acc[x][y] = __builtin_amdgcn_mfma_f32_32x32x16_bf16(a[x], bw[ks][y], acc[x][y], 0, 0, 0);
            } }
        { LAS unsigned char* stg = F.lds + 70656 + w * 9216;
#pragma unroll
          for (int y = 0; y < 2; ++y) { const float bsv = bs[g * 128 + 32 * (2 * tp + y) + r32];
#pragma unroll
              for (int x = 0; x < 2; ++x)
#pragma unroll
                  for (int jj = 0; jj < 4; ++jj) { u32x2 o; o.x = pk2(acc[x][y][jj * 4 + 0] + bsv, acc[x][y][jj * 4 + 1] + bsv); o.y = pk2(acc[x][y][jj * 4 + 2] + bsv, acc[x][y][jj * 4 + 3] + bsv);
                      *(LAS u32x2*)(stg + (32 * y + r32) * 144 + (32 * x + 8 * jj + 4 * h) * 2) = o; } }
          LDS_WAIT(); asm volatile("" ::: "memory");
          const int rr = lane >> 3, ch = lane & 7; const size_t gofs = (size_t)(row0 + 64 * tp + rr) * GD + g * 256 + 64 * dp + 8 * ch;
          bf16* G = (bf16*)(ws + WS_ACT);
#pragma unroll
          for (int it = 0; it < 8; ++it) { const u32x4 mx = *(const LAS u32x4*)(stg + (rr + 8 * it) * 144 + ch * 16); const u32x4 uu = *(const u32x4*)(U + gofs + (size_t)(8 * it) * GD); u32x4 o;
              o.x = pk2(bflo(uu.x) * bflo(mx.x), bfhi(uu.x) * bfhi(mx.x)); o.y = pk2(bflo(uu.y) * bflo(mx.y), bfhi(uu.y) * bfhi(mx.y));
              o.z = pk2(bflo(uu.z) * bflo(mx.z), bfhi(uu.z) * bfhi(mx.z)); o.w = pk2(bflo(uu.w) * bflo(mx.w), bfhi(uu.w) * bfhi(mx.w));
              *(u32x4*)(G + gofs + (size_t)(8 * it) * GD) = o; }
          LDS_WAIT(); asm volatile("" ::: "memory"); }
    }
}

__device__ __forceinline__ void p_router(Frame& F, int layer) {
    unsigned char* ws = F.ws;
    const bf16* HF = (const bf16*)(ws + WS_HF); const float* rw = F.in[I_RW] + (size_t)layer * D * NEXP; const float* rb = F.in[I_RB] + layer * NEXP; const float* gn = F.in[I_NFFN] + layer * D;
    int* lslot = (int*)(ws + WS_LSLOT); float* lw = (float*)(ws + WS_LW); float* lrs = (float*)(ws + WS_LRS);
    constexpr int WST = 1032;
    LAS bf16* Whi = (LAS bf16*)F.lds; LAS bf16* Wlo = Whi + 32 * WST;
    LAS float* lg = (LAS float*)(F.lds + 133120) + F.wave * 544;
    const int tid = (F.wave * 64 + lane_id()), lane = lane_id();
    __syncthreads();
    { f32x4 rv[16]; float gv[16];
#pragma unroll
      for (int it = 0; it < 16; ++it) { const int idx = (tid + 512 * it) * 4; rv[it] = *(const f32x4*)(rw + idx); gv[it] = gn[idx >> 5]; }
#pragma unroll
      for (int it = 0; it < 16; ++it) { const int idx = (tid + 512 * it) * 4, k = idx >> 5, e0 = idx & 31;
#pragma unroll
          for (int j = 0; j < 4; ++j) { const float v = rv[it][j] * gv[it]; const unsigned hi = f2bf(v);
              Whi[(e0 + j) * WST + k] = (bf16)hi; Wlo[(e0 + j) * WST + k] = (bf16)f2bf(v - bf2f((unsigned short)hi)); } } }
    __syncthreads();
    const int tok = lane & 15, q = lane >> 4;
    for (int grp = F.bx * NWAVES + F.wave; grp < NTOK / 16; grp += F.G * NWAVES) {
        const int t0 = grp * 16;
        f32x4 a0 = {0.f, 0.f, 0.f, 0.f}, a1 = {0.f, 0.f, 0.f, 0.f}; float ssq = 0.f;
        const bf16* hrow = HF + (size_t)(t0 + tok) * D + 8 * q;
        const LAS bf16* wrow = Whi + tok * WST + 8 * q;
#pragma unroll
        for (int jb = 0; jb < 2; ++jb) {
            u32x4 hb[16];
#pragma unroll
            for (int jj = 0; jj < 16; ++jj) hb[jj] = *(const u32x4*)(hrow + 32 * (16 * jb + jj));
#pragma unroll
            for (int jj = 0; jj < 16; ++jj) { const int j = 16 * jb + jj; const u32x4 hw = hb[jj]; const bf16x8 A = __builtin_bit_cast(bf16x8, hw);
                const float hv[8] = {bflo(hw.x), bfhi(hw.x), bflo(hw.y), bfhi(hw.y), bflo(hw.z), bfhi(hw.z), bflo(hw.w), bfhi(hw.w)};
#pragma unroll
                for (int m = 0; m < 8; ++m) ssq += hv[m] * hv[m];
                const LAS bf16* wp = wrow + 32 * j;
                const bf16x8 bh0 = *(const LAS bf16x8*)wp, bl0 = *(const LAS bf16x8*)(wp + 32 * WST), bh1 = *(const LAS bf16x8*)(wp + 16 * WST), bl1 = *(const LAS bf16x8*)(wp + 48 * WST);
                a0 = __builtin_amdgcn_mfma_f32_16x16x32_bf16(A, bh0, a0, 0, 0, 0); a0 = __builtin_amdgcn_mfma_f32_16x16x32_bf16(A, bl0, a0, 0, 0, 0);
                a1 = __builtin_amdgcn_mfma_f32_16x16x32_bf16(A, bh1, a1, 0, 0, 0); a1 = __builtin_amdgcn_mfma_f32_16x16x32_bf16(A, bl1, a1, 0, 0, 0); }
        }
        ssq = xsum32(xsum16(ssq));
#pragma unroll
        for (int i = 0; i < 4; ++i) { lg[(4 * q + i) * 32 + tok] = a0[i]; lg[(4 * q + i) * 32 + 16 + tok] = a1[i]; }
        if (q == 0) lg[512 + tok] = rstd_of(ssq);
        LDS_WAIT(); asm volatile("" ::: "memory");
        if (lane < 16) {
            const float rs = lg[512 + lane]; float v[4] = {-3.0e38f, -3.0e38f, -3.0e38f, -3.0e38f}; int ix[4] = {0, 0, 0, 0};
            for (int e = 0; e < 32; ++e) { const float x = lg[lane * 32 + e] * rs + rb[e];
                if (x > v[3]) { v[3] = x; ix[3] = e;
                    if (v[3] > v[2]) { float tv = v[2]; v[2] = v[3]; v[3] = tv; int ti = ix[2]; ix[2] = ix[3]; ix[3] = ti;
                        if (v[2] > v[1]) { tv = v[1]; v[1] = v[2]; v[2] = tv; ti = ix[1]; ix[1] = ix[2]; ix[2] = ti;
                            if (v[1] > v[0]) { tv = v[0]; v[0] = v[1]; v[1] = tv; ti = ix[0]; ix[0] = ix[1]; ix[1] = ti; } } } } }
            float ex[4], sum = 0.f;
#pragma unroll
            for (int k = 0; k < 4; ++k) { ex[k] = __expf(v[k] - v[0]); sum += ex[k]; }
            const float inv = 1.0f / sum; const int t = t0 + lane;
#pragma unroll
            for (int k = 0; k < 4; ++k) { const int e = ix[k]; const unsigned pos = __hip_atomic_fetch_add(F.ctl + CW_CNT + (layer * 32 + e) * 64, 1u, __ATOMIC_RELAXED, __HIP_MEMORY_SCOPE_AGENT);
                lslot[(size_t)e * NTOK + pos] = t * 4 + k; lw[(size_t)e * NTOK + pos] = ex[k] * inv; lrs[(size_t)e * NTOK + pos] = rs; }
        }
        LDS_WAIT(); asm volatile("" ::: "memory");
    }
    __syncthreads();
}

__device__ __forceinline__ void p_combine(Frame& F, unsigned char* hq, float* ssq1) {
    unsigned char* ws = F.ws; const bf16* HF = (const bf16*)(ws + WS_HF); bf16* HR = (bf16*)(ws + WS_HB0); const unsigned char* Y = ws + WS_Y;
    const int gw = F.bx * NWAVES + F.wave, NGW = F.G * NWAVES, lane = lane_id();
    for (int m0 = gw; m0 < NTOK; m0 += 2 * NGW) {
        f32x4 v[2][4]; unsigned yy[2][4][4];
#pragma unroll
        for (int r = 0; r < 2; ++r) { const int m = (m0 + r * NGW) < NTOK ? m0 + r * NGW : m0; const u32x2* hr = (const u32x2*)(HF + (size_t)m * D) + lane;
#pragma unroll
            for (int j = 0; j < 4; ++j) { const u32x2 hw = hr[64 * j]; v[r][j] = (f32x4){bflo(hw.x), bfhi(hw.x), bflo(hw.y), bfhi(hw.y)};
#pragma unroll
                for (int k = 0; k < 4; ++k) yy[r][j][k] = *((const unsigned*)(Y + ((size_t)m * 4 + k) * D) + lane + 64 * j); } }
#pragma unroll
        for (int r = 0; r < 2; ++r) { const int m = (m0 + r * NGW) < NTOK ? m0 + r * NGW : m0; float s = 0.f;
#pragma unroll
            for (int j = 0; j < 4; ++j) {
#pragma unroll
                for (int k = 0; k < 4; ++k) { const f32x2 lo = __builtin_amdgcn_cvt_pk_f32_fp8((int)yy[r][j][k], false), hi = __builtin_amdgcn_cvt_pk_f32_fp8((int)yy[r][j][k], true);
                    v[r][j].x += lo.x * (1.0f / F8_SY); v[r][j].y += lo.y * (1.0f / F8_SY); v[r][j].z += hi.x * (1.0f / F8_SY); v[r][j].w += hi.y * (1.0f / F8_SY); }
                s += sq4(v[r][j]); }
            s = wave_sum(s);
            u32x2* o8 = (u32x2*)(HR + (size_t)m * D) + lane; unsigned* o4 = (unsigned*)(hq + (size_t)m * D) + lane;
#pragma unroll
            for (int j = 0; j < 4; ++j) { o8[64 * j] = (u32x2){pk2(v[r][j].x, v[r][j].y), pk2(v[r][j].z, v[r][j].w)}; const f32x4 qv = v[r][j] * F8_SA; o4[64 * j] = pk4_fp8(qv.x, qv.y, qv.z, qv.w); }
            if (lane == 0) ssq1[m] = s; }
    }
}

__device__ __forceinline__ void p11_compress2(Frame& F) {
    unsigned char* ws = F.ws; const bf16* HID = (const bf16*)(ws + WS_HID); bf16* KCMP = (bf16*)(ws + WS_KCMP); bf16* VTCMP = (bf16*)(ws + WS_VTCMP);
    const float* knorm = F.in[I_KNORM];
    LAS float* w2 = (LAS float*)F.lds;
    const int tid = (F.wave * 64 + lane_id());
    int jl = -1;
    for (int unit = F.bx; unit < 256; unit += F.G) {
        const int j = unit >> 7, rb = unit & 127;
        if (j != jl) { __syncthreads(); const f32x4* src = (const f32x4*)(F.in[I_CMPW2] + (size_t)j * 256 * 64); f32x4 wv[8];
#pragma unroll
            for (int i = 0; i < 8; ++i) wv[i] = src[tid + NTHR * i];
#pragma unroll
            for (int i = 0; i < 8; ++i) ((LAS f32x4*)w2)[tid + NTHR * i] = wv[i];
            __syncthreads(); jl = j; }
        const int row = tid >> 3, dg = tid & 7, R = rb * 64 + row;
        const bf16* hr = HID + ((size_t)j * 8192 + R) * 256;
        float o[8] = {0.f, 0.f, 0.f, 0.f, 0.f, 0.f, 0.f, 0.f};
        u32x4 hall[32];
#pragma unroll
        for (int f8 = 0; f8 < 32; ++f8) hall[f8] = *(const u32x4*)(hr + f8 * 8);
#pragma unroll
        for (int f8 = 0; f8 < 32; ++f8) { const u32x4 hv = hall[f8]; const unsigned hw[4] = {hv.x, hv.y, hv.z, hv.w};
#pragma unroll
            for (int jj = 0; jj < 8; ++jj) { const float hval = (jj & 1) ? bfhi(hw[jj >> 1]) : bflo(hw[jj >> 1]); const LAS float* wr_ = w2 + (f8 * 8 + jj) * 64 + dg * 8;
                const f32x4 wa = *(const LAS f32x4*)wr_, wb = *(const LAS f32x4*)(wr_ + 4);
                o[0] += hval * wa.x; o[1] += hval * wa.y; o[2] += hval * wa.z; o[3] += hval * wa.w; o[4] += hval * wb.x; o[5] += hval * wb.y; o[6] += hval * wb.z; o[7] += hval * wb.w; } }
        const int bg = R >> 9, n = R & 511; const bool pad = (n == NCMP);
        if (j == 0) { float ss = 0.f;
#pragma unroll
            for (int k = 0; k < 8; ++k) ss += o[k] * o[k];
            ss += __shfl_xor(ss, 1); ss += __shfl_xor(ss, 2); ss += __shfl_xor(ss, 4);
            const float r2 = pad ? 0.f : __builtin_amdgcn_rsqf(ss * (1.0f / 64.0f) + EPS);
            f32x4 a, b;
#pragma unroll
            for (int k = 0; k < 4; ++k) { a[k] = o[k] * r2 * knorm[dg * 8 + k]; b[k] = o[4 + k] * r2 * knorm[dg * 8 + 4 + k]; }
            if (pad) { a = (f32x4){0.f, 0.f, 0.f, 0.f}; b = a; }
            *(u32x4*)(KCMP + (size_t)R * 64 + dg * 8) = pack8(a, b);
        } else {
#pragma unroll
            for (int k = 0; k < 8; ++k) VTCMP[((size_t)bg * 64 + dg * 8 + k) * 512 + ((n & ~12) | ((n & 4) << 1) | ((n & 8) >> 1))] = (bf16)f2bf(pad ? 0.f : o[k]);
        }
    }
}

constexpr int TABW = 1644;
constexpr int AT_RING = 0, AT_SLOT = 16384, AT_IMPG = 65536, AT_IMPH = AT_IMPG + 32768, AT_TABD = AT_IMPH + 32768, AT_NEG = AT_TABD + 4 * TABW * 4, AT_SELM = AT_NEG + 512, AT_INVL = AT_SELM + 1024, AT_END = AT_INVL + 1024;
static_assert(AT_END <= LDS_BYTES - 256, "attention LDS map");
__device__ __forceinline__ int t5_bucket_dev(int n) {
    if (n < 16) return n;
    int b = 16;
    b += n >= 22; b += n >= 30; b += n >= 40; b += n >= 54; b += n >= 73; b += n >= 99; b += n >= 134; b += n >= 182; b += n >= 246; b += n >= 332; b += n >= 450; b += n >= 609; b += n >= 825; b += n >= 1117; b += n >= 1513;
    return b;
}
__device__ __forceinline__ void at_stage(LAS unsigned char* lds, int slot, const bf16* k, const bf16* vt, int vt_ld, int w, int lane) {
    const int row = 8 * w + (lane >> 3), ch = (lane & 7) ^ ((row >> 1) & 7);
    __builtin_amdgcn_global_load_lds((const unsigned*)(k + (size_t)row * 64 + ch * 8), (LAS unsigned*)(lds + AT_RING + slot * AT_SLOT + w * 1024), 16, 0, 0);
    __builtin_amdgcn_global_load_lds((const unsigned*)(vt + (size_t)row * vt_ld + ch * 8), (LAS unsigned*)(lds + AT_RING + slot * AT_SLOT + 8192 + w * 1024), 16, 0, 0);
}
__device__ __forceinline__ f32x16 at_scores(const LAS unsigned char* blk, int kt, int r32, int h, const bf16x8 (&qf)[4]) {
    f32x16 st;
#pragma unroll
    for (int k = 0; k < 16; ++k) st[k] = 0.f;
    const int row = 32 * kt + r32, sw = (row >> 1) & 7;
#pragma unroll
    for (int ks = 0; ks < 4; ++ks) { const bf16x8 a = *(const LAS bf16x8*)(blk + row * 128 + (((2 * ks + h) ^ sw) << 4)); st = __builtin_amdgcn_mfma_f32_32x32x16_bf16(a, qf[ks], st, 0, 0, 0); }
    return st;
}
__device__ __forceinline__ unsigned cvt_pk_bf16(float lo, float hi) { unsigned r; asm volatile("v_cvt_pk_bf16_f32 %0, %1, %2" : "=v"(r) : "v"(lo), "v"(hi)); return r; }
__device__ __forceinline__ bf16x8 at_packp(const f32x16& p, int m) {
    const u32x4 w = {cvt_pk_bf16(p[8 * m + 0], p[8 * m + 1]), cvt_pk_bf16(p[8 * m + 2], p[8 * m + 3]), cvt_pk_bf16(p[8 * m + 4], p[8 * m + 5]), cvt_pk_bf16(p[8 * m + 6], p[8 * m + 7])};
    return __builtin_bit_cast(bf16x8, w);
}
__device__ __forceinline__ void at_pv(const LAS unsigned char* blk, int kt, int r32, int h, const f32x16& p, f32x16 (&o)[2]) {
#pragma unroll
    for (int m = 0; m < 2; ++m) { const bf16x8 pb = at_packp(p, m);
#pragma unroll
        for (int dt = 0; dt < 2; ++dt) { const int d = 32 * dt + r32, sw = (d >> 1) & 7;
            const bf16x8 a = *(const LAS bf16x8*)(blk + 8192 + d * 128 + (((4 * kt + 2 * m + h) ^ sw) << 4));
            o[dt] = __builtin_amdgcn_mfma_f32_32x32x16_bf16(a, pb, o[dt], 0, 0, 0); } }
}
template <int STEP> __device__ __forceinline__ void at_softmax(f32x16& st, int cls, int dl, const LAS float* tabr, const LAS float* negr, int wlim, bool lane_ok) {
    constexpr float L2E = 1.44269504089f;
    if (cls == 0) { const float tb = lane_ok ? tabr[1513] : -1.0e30f;
#pragma unroll
        for (int k = 0; k < 16; ++k) st[k] = fast_exp2(st[k] * L2E + tb);
    } else if (cls == 1) { const LAS float* tq = (lane_ok ? tabr + dl : negr + 64 * STEP) - 27 * STEP; asm("" : "+v"(tq));
#pragma unroll
        for (int k = 0; k < 16; ++k) st[k] = fast_exp2(st[k] * L2E + tq[STEP * (27 - (8 * (k >> 2) + (k & 3)))]);
    } else {
        float tb[16]; const LAS float* tq = tabr + dl - 27 * STEP; asm("" : "+v"(tq));
#pragma unroll
        for (int k = 0; k < 16; ++k) { const int d = dl - STEP * (8 * (k >> 2) + (k & 3));
            if (STEP == 1) tb[k] = tq[27 - (8 * (k >> 2) + (k & 3))];
            else { const int dc = d < 0 ? 0 : (d > 1513 ? 1513 : d); tb[k] = tabr[dc]; } }
#pragma unroll
        for (int k = 0; k < 16; ++k) { const int d = dl - STEP * (8 * (k >> 2) + (k & 3)); const bool ok = lane_ok && (unsigned)d < (unsigned)wlim;
            st[k] = fast_exp2(st[k] * L2E + (ok ? tb[k] : -1.0e30f)); }
    }
}
__device__ __forceinline__ int at_class(int dmin, int dmax, int wlim) { return dmin >= 1513 && dmax < wlim ? 0 : ((dmin >= 0 && dmax <= 1640 && dmax < wlim) ? 1 : 2); }
__device__ __forceinline__ float fadd_(float a, float b) { float r; asm("v_add_f32 %0, %1, %2" : "=v"(r) : "v"(a), "v"(b)); return r; }
__device__ __forceinline__ float at_sum16(const f32x16& p) { return fadd_(fadd_(fadd_(fadd_(p[0], p[1]), fadd_(p[2], p[3])), fadd_(fadd_(p[4], p[5]), fadd_(p[6], p[7]))), fadd_(fadd_(fadd_(p[8], p[9]), fadd_(p[10], p[11])), fadd_(fadd_(p[12], p[13]), fadd_(p[14], p[15])))); }
#define AT_WAITV(n) asm volatile("s_waitcnt vmcnt(" #n ")" ::: "memory")
#define AT_BAR() do { asm volatile("" ::: "memory"); __builtin_amdgcn_s_barrier(); asm volatile("" ::: "memory"); } while (0)

__device__ __forceinline__ void p12_attention(Frame& F) {
    unsigned char* ws = F.ws; LAS unsigned char* lds = F.lds;
    const bf16* Q = (const bf16*)(ws + WS_Q); const float* GATES = (const float*)(ws + WS_GATES); unsigned char* AO = ws + WS_AOQ;
    const float* relb = F.in[I_RELB];
    const int tid0 = (F.wave * 64 + lane_id()), lane0 = lane_id(), w = F.wave;
    LAS float* IMPG = (LAS float*)(lds + AT_IMPG); LAS float* IMPH = (LAS float*)(lds + AT_IMPH);
    LAS float* TABD = (LAS float*)(lds + AT_TABD); LAS unsigned* SELM = (LAS unsigned*)(lds + AT_SELM);
    constexpr float L2E = 1.44269504089f; constexpr int BIG = 1 << 30;
    const int bg = F.bx & 15, b = bg >> 2, g = bg & 3;
    const bf16* kc0 = (const bf16*)(ws + WS_KCMP) + (size_t)bg * 512 * 64; const bf16* vc0 = (const bf16*)(ws + WS_VTCMP) + (size_t)bg * 64 * 512;
    const bf16* ks0 = (const bf16*)(ws + WS_KSEL) + (size_t)bg * SEQ * 64; const bf16* vs0 = (const bf16*)(ws + WS_VTSEL) + (size_t)bg * 64 * SEQ;
    const bf16* kw0 = (const bf16*)(ws + WS_KWIN) + (size_t)bg * SEQ * 64; const bf16* vw0 = (const bf16*)(ws + WS_VTWIN) + (size_t)bg * 64 * SEQ;
    float mq = fabsf(F.in[I_QNORM][lane0]), mk = fmaxf(fabsf(F.in[I_KNORM][lane0]), fmaxf(fabsf(F.in[I_KNORM][64 + lane0]), fabsf(F.in[I_KNORM][128 + lane0]))), mb = 0.f;
    for (int k = lane0; k < 512; k += 64) mb = fmaxf(mb, fabsf(relb[k]));
#pragma unroll
    for (int o = 1; o < 64; o <<= 1) { mq = fmaxf(mq, __shfl_xor(mq, o)); mk = fmaxf(mk, __shfl_xor(mk, o)); mb = fmaxf(mb, __shfl_xor(mb, o)); }
    const float Msh = 8.0f * mq * mk + mb;
    __syncthreads();
    for (int k = tid0; k < 4 * TABW; k += NTHR) { const int rr = k / TABW, d = k % TABW; TABD[k] = (relb[t5_bucket_dev(d) * 16 + g * 4 + rr] - Msh) * L2E; }
    if (tid0 < 128) ((LAS float*)(lds + AT_NEG))[tid0] = -1.0e30f;
    __syncthreads();
    int kslice = 0;
    for (int un = F.bx; un < 2048; un += F.G) {
        const int i = 16 * (un >> 8) + (((un >> 8) & 1) ? 15 - ((un >> 4) & 15) : ((un >> 4) & 15));
        int tid = tid0; asm volatile("" : "+v"(tid));
        const int lane = tid & 63, r32 = lane & 31, h = lane >> 5, c = r32, r = c & 3;
        const LAS float* tabr = TABD + r * TABW; const LAS float* negr = (const LAS float*)(lds + AT_NEG);
        const int tl = 8 * w + (c >> 2), t = 64 * i + tl, head = g * 4 + r; const size_t tokrow = (size_t)b * SEQ + t;
        const int tmin = 64 * i + 8 * w, tmax = tmin + 7;
        const int nvis = (4 * i + 3) < NCMP ? (4 * i + 3) : NCMP, nst = (nvis + 63) >> 6;
#define AT_RING_BEGIN(kb, vb, ld, n) do { _Pragma("unroll") for (int _p = 0; _p < 3; ++_p) { const int _bb = _p < (n) ? _p : (n) - 1; at_stage(lds, _p, (kb) + (size_t)_bb * 64 * 64, (vb) + _bb * 64, (ld), w, lane); } } while (0)
#define AT_RING_STEP(kb, vb, ld, n, s) do { AT_WAITV(4); AT_BAR(); { const int _bb = (s) + 3 < (n) ? (s) + 3 : (n) - 1; at_stage(lds, ((s) + 3) & 3, (kb) + (size_t)_bb * 64 * 64, (vb) + _bb * 64, (ld), w, lane); } } while (0)
#define AT_RING_END() do { AT_WAITV(0); AT_BAR(); } while (0)
        AT_RING_BEGIN(kc0, vc0, 512, nst);
        bf16x8 qf[4];
#pragma unroll
        for (int ks = 0; ks < 4; ++ks) qf[ks] = *(const bf16x8*)(Q + tokrow * D + head * 64 + 16 * ks + 8 * h);
        const float gt_c = GATES[tokrow * 48 + head], gt_s = GATES[tokrow * 48 + 16 + head], gt_w = GATES[tokrow * 48 + 32 + head];
        f32x16 otot[2], obr[2];
#pragma unroll
        for (int dt = 0; dt < 2; ++dt)
#pragma unroll
            for (int k = 0; k < 16; ++k) { otot[dt][k] = 0.f; obr[dt][k] = 0.f; }
        float lsum = 0.f, hcarry = 0.f;
        LAS bf16* IMP16 = (LAS bf16*)(lds + AT_IMPG); LAS float* INVL = (LAS float*)(lds + AT_INVL);
        for (int sp = 0; sp < nst; ++sp) {
            AT_RING_STEP(kc0, vc0, 512, nst, sp);
            const LAS unsigned char* blk = lds + AT_RING + (sp & 3) * AT_SLOT;
#pragma unroll
            for (int kt = 0; kt < 2; ++kt) { const int ct = 2 * sp + kt;
                if (32 * ct < nvis) {
                    f32x16 st = at_scores(blk, kt, r32, h, qf);
                    const int cls = at_class(tmin - (512 * ct + 527), tmax - (512 * ct + 31), BIG);
                    at_softmax<16>(st, cls, t - 512 * ct - 31 - 64 * h, tabr, negr, BIG, true);
                    lsum += at_sum16(st);
                    at_pv(blk, kt, r32, h, st, obr);
                    float xh[4];
#pragma unroll
                    for (int jj = 0; jj < 4; ++jj) xh[jj] = __shfl_xor(0.5f * st[jj * 4 + 3], 32);
#pragma unroll
                    for (int jj = 0; jj < 4; ++jj) { const float gsum = (st[jj * 4] + st[jj * 4 + 1]) + (st[jj * 4 + 2] + 0.5f * st[jj * 4 + 3]);
                        const float recv = h ? xh[jj] : (jj ? xh[jj > 0 ? jj - 1 : 0] : hcarry);
                        IMP16[(r * 64 + tl) * 128 + 8 * ct + 2 * jj + h] = (bf16)f2bf(gsum + recv); }
                    hcarry = xh[3];
                } }
        }
        AT_RING_END();
        lsum += __shfl_xor(lsum, 32); const float invl = lsum > 0.f ? 1.0f / lsum : 0.f;
        if (h == 0) INVL[tl * 4 + r] = invl;
        AT_RING_BEGIN(ks0, vs0, SEQ, i + 1);
#pragma unroll
        for (int dt = 0; dt < 2; ++dt)
#pragma unroll
            for (int k = 0; k < 16; ++k) { otot[dt][k] = (gt_c * invl) * obr[dt][k]; obr[dt][k] = 0.f; }
        { const int j = lane >> 3, part = lane & 7, tj = 8 * w + j;
          unsigned m[4] = {0u, 0u, 0u, 0u};
          if (i <= 15) m[0] = (2u << i) - 1u;
          else {
              unsigned key[16];
              float imp[16];
#pragma unroll
              for (int e = 0; e < 16; ++e) imp[e] = 0.f;
#pragma unroll
              for (int rr = 0; rr < 4; ++rr) { const float il = INVL[tj * 4 + rr]; const LAS u32x4* ip = (const LAS u32x4*)(IMP16 + (rr * 64 + tj) * 128 + 16 * part); const u32x4 w0 = ip[0], w1 = ip[1];
                  const unsigned ww[8] = {w0.x, w0.y, w0.z, w0.w, w1.x, w1.y, w1.z, w1.w};
#pragma unroll
                  for (int e = 0; e < 8; ++e) { imp[2 * e] += il * bflo(ww[e]); imp[2 * e + 1] += il * bfhi(ww[e]); } }
#pragma unroll
              for (int e = 0; e < 16; ++e) { const int s = 16 * part + e; const bool okc = s >= 1 && s <= i - 2;
                  key[e] = okc ? ((__builtin_bit_cast(unsigned, imp[e]) & ~127u) | (unsigned)(127 - s)) : 0u; }
              for (int rd = 0; rd < 13; ++rd) { unsigned best = key[0];
#pragma unroll
                  for (int e = 1; e < 16; ++e) best = best > key[e] ? best : key[e];
                  { unsigned o1 = (unsigned)__builtin_amdgcn_update_dpp(0, (int)best, 0xB1, 0xF, 0xF, false); best = best > o1 ? best : o1;
                    o1 = (unsigned)__builtin_amdgcn_update_dpp(0, (int)best, 0x4E, 0xF, 0xF, false); best = best > o1 ? best : o1;
                    o1 = (unsigned)__builtin_amdgcn_update_dpp(0, (int)best, 0x141, 0xF, 0xF, false); best = best > o1 ? best : o1; }
                  const int sb = 127 - (int)(best & 127u);
#pragma unroll
                  for (int x = 0; x < 4; ++x) m[x] |= ((sb >> 5) == x) ? (1u << (sb & 31)) : 0u;
#pragma unroll
                  for (int e = 0; e < 16; ++e) key[e] = key[e] == best ? 0u : key[e]; }
              m[0] |= 1u;
#pragma unroll
              for (int x = 0; x < 4; ++x) { m[x] |= (((i - 1) >> 5) == x) ? (1u << ((i - 1) & 31)) : 0u; m[x] |= ((i >> 5) == x) ? (1u << (i & 31)) : 0u; }
          }
          if (part == 0) { SELM[tj * 4] = m[0]; SELM[tj * 4 + 1] = m[1]; SELM[tj * 4 + 2] = m[2]; SELM[tj * 4 + 3] = m[3]; }
        }
        LDS_WAIT(); asm volatile("" ::: "memory");
        unsigned sm[4];
#pragma unroll
        for (int x = 0; x < 4; ++x) sm[x] = SELM[tl * 4 + x];
        { lsum = 0.f;
          for (int s = 0; s <= i; ++s) {
              AT_RING_STEP(ks0, vs0, SEQ, i + 1, s);
              const LAS unsigned char* blk = lds + AT_RING + (s & 3) * AT_SLOT;
              const unsigned word = s < 32 ? sm[0] : s < 64 ? sm[1] : s < 96 ? sm[2] : sm[3]; const bool sel = (word >> (s & 31)) & 1u;
              if (__builtin_amdgcn_ballot_w64(sel) != 0ull) {
#pragma unroll
                  for (int kt = 0; kt < 2; ++kt) { const int pos0 = 64 * s + 32 * kt;
                      f32x16 st = at_scores(blk, kt, r32, h, qf);
                      const int cls = at_class(tmin - (pos0 + 31), tmax - pos0, BIG);
                      at_softmax<1>(st, cls, t - pos0 - 4 * h, tabr, negr, BIG, sel);
                      lsum += at_sum16(st);
                      at_pv(blk, kt, r32, h, st, obr); }
              }
          }
          AT_RING_END();
          lsum += __shfl_xor(lsum, 32); const float sc = lsum > 0.f ? gt_s / lsum : 0.f;
#pragma unroll
          for (int dt = 0; dt < 2; ++dt)
#pragma unroll
              for (int k = 0; k < 16; ++k) { otot[dt][k] += sc * obr[dt][k]; obr[dt][k] = 0.f; }
        }
        { const int p0 = (64 * i - 512) < 0 ? 0 : (64 * i - 512), nst2 = (64 * i + 64 - p0) >> 6;
          const bf16* k0 = kw0 + (size_t)p0 * 64; const bf16* v0 = vw0 + p0;
          lsum = 0.f;
          AT_RING_BEGIN(k0, v0, SEQ, nst2);
          for (int sp = 0; sp < nst2; ++sp) {
              AT_RING_STEP(k0, v0, SEQ, nst2, sp);
              const LAS unsigned char* blk = lds + AT_RING + (sp & 3) * AT_SLOT;
#pragma unroll
              for (int kt = 0; kt < 2; ++kt) { const int pos0 = p0 + 64 * sp + 32 * kt;
                  f32x16 st = at_scores(blk, kt, r32, h, qf);
                  const int cls = at_class(tmin - (pos0 + 31), tmax - pos0, 512);
                  at_softmax<1>(st, cls, t - pos0 - 4 * h, tabr, negr, 512, true);
                  lsum += at_sum16(st);
                  at_pv(blk, kt, r32, h, st, obr); }
          }
          AT_RING_END();
          lsum += __shfl_xor(lsum, 32); const float sc = lsum > 0.f ? gt_w / lsum : 0.f;
#pragma unroll
          for (int dt = 0; dt < 2; ++dt)
#pragma unroll
              for (int k = 0; k < 16; ++k) otot[dt][k] += sc * obr[dt][k];
        }
        unsigned char* orow = AO + tokrow * D + head * 64;
#pragma unroll
        for (int dt = 0; dt < 2; ++dt)
#pragma unroll
            for (int jj = 0; jj < 4; ++jj) *(unsigned*)(orow + 32 * dt + 8 * jj + 4 * h) = pk4_fp8(otot[dt][jj * 4] * F8_SA, otot[dt][jj * 4 + 1] * F8_SA, otot[dt][jj * 4 + 2] * F8_SA, otot[dt][jj * 4 + 3] * F8_SA);
        conv_l1_slice(F, kslice, (LAS float*)(lds + w * 8448)); ++kslice;
        LDS_WAIT(); AT_BAR();
    }
    for (; kslice * F.G * NWAVES < 16384; ++kslice) conv_l1_slice(F, kslice, (LAS float*)(lds + w * 8448));
#undef AT_RING_BEGIN
#undef AT_RING_STEP
#undef AT_RING_END
    __syncthreads();
}

constexpr int N_PHASES = 19;
struct Args { const float* in[31]; float* out; unsigned char* ws; int ph_lo, ph_hi, li, pad; };
__global__ void __launch_bounds__(NTHR, 2) trunk_fwd(Args args) {
    extern __shared__ __attribute__((aligned(16))) unsigned char lds_raw[];
    Frame F;
    F.lds = (LAS unsigned char*)lds_raw;
    F.wave = __builtin_amdgcn_readfirstlane((int)threadIdx.x >> 6);
    F.G = gridDim.x; F.bx = blockIdx.x; F.pw_done = 0; F.ws = args.ws; F.ctl = (unsigned*)(args.ws + WS_CTL); F.out = args.out;
    F.in = (const float* const __attribute__((address_space(4)))*)__builtin_amdgcn_kernarg_segment_ptr();
    volatile LAS unsigned* MISC = (volatile LAS unsigned*)(F.lds + LDS_MISC);
    if ((F.wave * 64 + lane_id()) < 64) MISC[(F.wave * 64 + lane_id())] = 0u;
    __syncthreads();
    XcdBarrier bar; bar.bar = F.ctl + CW_BAR + args.li * XCD_BAR_WORDS; bar.x = 0; bar.st = nullptr; bar.wave = F.wave;
    if (args.ph_hi - args.ph_lo > 1) bar = xcd_barrier_post(F.ctl + CW_BAR + args.li * XCD_BAR_WORDS, MISC + 8, F.wave);
    const int lo = args.ph_lo, hi = args.ph_hi;
    unsigned char* ws = args.ws;
#define IN(k) (lo <= (k) && (k) < hi)
#define SEAM(k) do { if (IN(k) && IN((k) + 1)) xcd_barrier(bar); } while (0)
    bf16* HF = (bf16*)(ws + WS_HF); bf16* HB0 = (bf16*)(ws + WS_HB0); bf16* HB1 = (bf16*)(ws + WS_HB1);
    float* SSQ1 = (float*)(ws + WS_SSQ1); float* SSQ16 = (float*)(ws + WS_SSQ16);

    if (IN(0)) { p0_prologue(F); } SEAM(0);

    if (IN(1)) {
        SchedPlain S; S.so.init(NTOK / 256, 16, F.G, F.bx); S.A = HB0; S.Bt = (const bf16*)(ws + WS_WAIN); S.lda = D; S.K = D;
        EpiGelu E{(bf16*)(ws + WS_U), (bf16*)(ws + WS_V), SSQ1, (float*)(ws + WS_LNP)};
        g8::gemm_phase<EpiGelu, SchedPlain, false>(F.lds, D, D, S, E, F.wave);
    } SEAM(1);

    if (IN(2)) { p2_spatial(F); } SEAM(2);

    if (IN(3)) {
        SchedPlain S; S.so.init(NTOK / 256, 4, F.G, F.bx); S.A = (const bf16*)(ws + WS_ACT); S.Bt = (const bf16*)(ws + WS_WAOUT); S.lda = GD; S.K = GD;
        EpiResid<false> E{F.in[I_X], HF, ws + WS_HQ, 1.0f};
        g8::gemm_phase<EpiResid<false>, SchedPlain, false>(F.lds, GD, GD, S, E, F.wave);
    } SEAM(3);

    if (IN(4)) { p_router(F, 0); } SEAM(4);

#define PW_TAIL(NN_) do { const int _nU = T.ntile * (NN_), _R = _nU % F.G, _nid = _R ? F.G - _R : 0; int _take = 2 * _nid; if (_take > 1024 - F.pw_done) _take = 1024 - F.pw_done; \
        if (_take > 0 && F.bx >= _R) { SchedPw S2{F.pw_done + (F.bx - _R), _nid, 2, F.pw_done + _take, (const bf16*)(ws + WS_PB), (const bf16*)(ws + WS_WPL)}; EpiPw E2{(bf16*)(ws + WS_PW)}; \
            g8::gemm_phase<EpiPw, SchedPw, false>(F.lds, PLE, PLE, S2, E2, F.wave); } \
        F.pw_done += _take; } while (0)
#define PW_REST(LIM_) do { if (F.pw_done < (LIM_)) { SchedPw S2{F.pw_done + F.bx, F.G, 1 << 20, (LIM_), (const bf16*)(ws + WS_PB), (const bf16*)(ws + WS_WPL)}; EpiPw E2{(bf16*)(ws + WS_PW)}; \
            g8::gemm_phase<EpiPw, SchedPw, false>(F.lds, PLE, PLE, S2, E2, F.wave); F.pw_done = (LIM_); } } while (0)

#define MOE_LAYER(P5, L, HBIN, SSQIN, HBOUT, SSQOUT) \
    if (IN(P5)) { const MoeTab T = moe_build_tab(F, L);   \
        SchedMoe<8, 2> S; S.init(T, F.G, F.bx); S.A = (const char*)(ws + WS_HQ); S.W = (const char*)(ws + WS_WGU) + (size_t)(L) * NEXP * 2048 * D; S.lslot = (const int*)(ws + WS_LSLOT); S.gather = 1; S.wstride = (size_t)2048 * D; S.rowb = D; \
        EpiMoe1 E{ws + WS_ACT, F.in[I_EBGU] + (size_t)(L) * NEXP * 2048, (const float*)(ws + WS_LRS)}; \
        g8::gemm_phase<EpiMoe1, SchedMoe<8, 2>, true, true>(F.lds, D / 2, D / 2, S, E, F.wave); PW_TAIL(8); } SEAM(P5); \
    if (IN(P5 + 1)) { const MoeTab T = moe_build_tab(F, L); \
        SchedMoe<4, 8> S; S.init(T, F.G, F.bx); S.A = (const char*)(ws + WS_ACT); S.W = (const char*)(ws + WS_WD) + (size_t)(L) * NEXP * D * D; S.lslot = (const int*)(ws + WS_LSLOT); S.gather = 0; S.wstride = (size_t)D * D; S.rowb = D; \
        EpiMoe2 E{ws + WS_Y, F.in[I_EBD] + (size_t)(L) * NEXP * D, (const int*)(ws + WS_LSLOT), (const float*)(ws + WS_LW), ws + WS_TRASH}; \
        g8::gemm_phase<EpiMoe2, SchedMoe<4, 8>, false, true>(F.lds, D / 2, D / 2, S, E, F.wave); PW_TAIL(4); } SEAM(P5 + 1); \
    if (IN(P5 + 2)) { PW_REST(512 * ((L) + 1)); p_combine(F, HBOUT, SSQOUT); } SEAM(P5 + 2);

    MOE_LAYER(5, 0, 0, 0, ws + WS_HQ2, SSQ1 + NTOK)

    if (IN(8)) {
        SchedPlain S; S.so.init(NTOK / 256, 4, F.G, F.bx); S.A = (const bf16*)(ws + WS_HQ2); S.Bt = (const bf16*)(ws + WS_WPG); S.lda = D / 2; S.K = D / 2;
        EpiPle<false> E{HB0, (const bf16*)(ws + WS_PW), SSQ1 + NTOK, ws + WS_HQ3, (unsigned long long*)(ws + WS_SSQ1 + 512 * 1024), nullptr};
        g8::gemm_phase<EpiPle<false>, SchedPlain, false, true>(F.lds, D / 2, D / 2, S, E, F.wave);
    } SEAM(8);

    if (IN(9)) {
        SchedPlain S; S.so.init(NTOK / 256, NKVQ / 256 - 1, F.G, F.bx); S.A = (const bf16*)(ws + WS_HQ3); S.Bt = (const bf16*)(ws + WS_WKVQ);     S.lda = D / 2; S.K = D / 2;
        EpiKvq E{(const unsigned long long*)(ws + WS_SSQ1 + 512 * 1024), (bf16*)(ws + WS_KC), (bf16*)(ws + WS_VC), (bf16*)(ws + WS_KSEL), (bf16*)(ws + WS_VTSEL), (bf16*)(ws + WS_KWIN), (bf16*)(ws + WS_VTWIN),
                 (bf16*)(ws + WS_Q), (float*)(ws + WS_GATES), F.in[I_KNORM], F.in[I_QNORM], F.in[I_BBGATE]};
        g8::gemm_phase<EpiKvq, SchedPlain, false, true>(F.lds, D / 2, D / 2, S, E, F.wave);
    } SEAM(9);

    if (IN(10)) {
        const bool split = F.G >= 128; const int nc = split ? 64 : F.G;
        if (F.bx < nc) {
            SchedPair S; S.so.init(64, 1, nc, F.bx); S.A0 = (const bf16*)(ws + WS_KC); S.A1 = (const bf16*)(ws + WS_VC); S.B0 = (const bf16*)(ws + WS_WC1); S.B1 = S.B0 + (size_t)256 * 2048; S.lda = 1024; S.K = 2048; S.nMh = 32;
            EpiCmp E{(bf16*)(ws + WS_HID), (const float*)(ws + WS_CB1), 32};
            g8::gemm_phase<EpiCmp, SchedPair, false>(F.lds, 2048, 1024, S, E, F.wave); }
        if (!split || F.bx >= nc) {
            SchedPlain S; S.so.init(NTOK / 256, 1, split ? F.G - nc : F.G, split ? F.bx - nc : F.bx); S.A = (const bf16*)(ws + WS_HQ3); S.Bt = (const bf16*)(ws + WS_WKVQ + (size_t)2560 * D); S.lda = D / 2; S.K = D / 2;
            EpiGates E{(const unsigned long long*)(ws + WS_SSQ1 + 512 * 1024), (float*)(ws + WS_GATES), F.in[I_BBGATE]};
            g8::gemm_phase<EpiGates, SchedPlain, false, true>(F.lds, D / 2, D / 2, S, E, F.wave); }
    } SEAM(10);

    if (IN(11)) { p11_compress2(F); } SEAM(11);

    if (IN(12)) { p12_attention(F); } SEAM(12);

    if (IN(13)) {
        SchedPlain S; S.so.init(NTOK / 256, 4, F.G, F.bx); S.A = (const bf16*)(ws + WS_AOQ); S.Bt = (const bf16*)(ws + WS_WO); S.lda = D / 2; S.K = D / 2;
        EpiResid<true> E{HB0, HF, ws + WS_HQ, 1.0f / (F8_SA * F8_SW)};
        g8::gemm_phase<EpiResid<true>, SchedPlain, false, true>(F.lds, D / 2, D / 2, S, E, F.wave);
    } SEAM(13);

    if (IN(14)) { p_router(F, 1); } SEAM(14);

    MOE_LAYER(15, 1, 0, 0, ws + WS_HQ2, SSQ1 + 2 * NTOK)

    if (IN(18)) {
        SchedPlain S; S.so.init(NTOK / 256, 4, F.G, F.bx); S.A = (const bf16*)(ws + WS_HQ2); S.Bt = (const bf16*)(ws + WS_WPG + (size_t)D * D); S.lda = D / 2; S.K = D / 2;
        EpiPle<true> E{HB0, (const bf16*)(ws + WS_PW) + (size_t)NTOK * D, SSQ1 + 2 * NTOK, nullptr, nullptr, F.out};
        g8::gemm_phase<EpiPle<true>, SchedPlain, false, true>(F.lds, D / 2, D / 2, S, E, F.wave);
    }
#undef IN
#undef SEAM
}

extern "C" void kernel_launch(void* const* d_in, const int* in_sizes, int n_in, void* d_out, int out_size, void* d_ws, size_t ws_size, hipStream_t stream) {
    static int grid = 0;
    if (grid == 0) {
        if (n_in != 31 || out_size != NTOK * D || ws_size < WS_END) { fprintf(stderr, "kernel_launch: unexpected problem (n_in %d, out %d, ws %zu < %zu)\n", n_in, out_size, ws_size, (size_t)WS_END); grid = -1; return; }
        int dev = 0, cus = 0, per_cu = 0;
        if (hipGetDevice(&dev) != hipSuccess || hipDeviceGetAttribute(&cus, hipDeviceAttributeMultiprocessorCount, dev) != hipSuccess) { grid = -1; return; }
        if (hipFuncSetAttribute((const void*)trunk_fwd, hipFuncAttributeMaxDynamicSharedMemorySize, LDS_BYTES) != hipSuccess) { fprintf(stderr, "kernel_launch: hipFuncSetAttribute failed\n"); grid = -1; return; }
        if (hipOccupancyMaxActiveBlocksPerMultiprocessor(&per_cu, (const void*)trunk_fwd, NTHR, LDS_BYTES) != hipSuccess || per_cu < 1)
            fprintf(stderr, "kernel_launch: occupancy query reports %d workgroups per CU\n", per_cu);
        (void)hipGetLastError();
        grid = cus;
    }
    if (grid < 0) return;
    (void)hipMemsetAsync((char*)d_ws + WS_CTL, 0, CTL_ZERO_BYTES, stream);
    Args a{};
    for (int i = 0; i < 31; ++i) a.in[i] = (const float*)d_in[i];
    a.out = (float*)d_out; a.ws = (unsigned char*)d_ws;
    const int plan[] = { PHASE_PLAN };
    constexpr int nl = (int)(sizeof(plan) / sizeof(int)) / 2;
    static_assert(nl >= 1 && nl <= 7, "at most 7 barrier regions below CW_CNT");
    for (int li = 0; li < nl; ++li) { a.ph_lo = plan[2 * li]; a.ph_hi = plan[2 * li + 1]; a.li = li; hipLaunchKernelGGL(trunk_fwd, dim3(grid), dim3(NTHR), LDS_BYTES, stream, a); }
    const hipError_t le = hipPeekAtLastError();
    if (le != hipSuccess) fprintf(stderr, "kernel_launch: launch failed: %s\n", hipGetErrorName(le));
}
```

```cpp
#include <hip/hip_runtime.h>
#include <cstdio>
#include <cstdint>

#ifndef PROBE_ATT
#define PROBE_ATT 0
#endif
#ifndef PROBE_EREP
#define PROBE_EREP 0
#endif
#ifndef PROBE_KREP
#define PROBE_KREP 1
#endif
#ifndef PHASE_PLAN
#define PHASE_PLAN 0, 19
#endif

#define GAS __attribute__((address_space(1)))
#define LAS __attribute__((address_space(3)))
typedef unsigned short bf16;
typedef short bf16x8 __attribute__((ext_vector_type(8)));
typedef float f32x4 __attribute__((ext_vector_type(4)));
typedef float f32x2 __attribute__((ext_vector_type(2)));
typedef float f32x16 __attribute__((ext_vector_type(16)));
typedef unsigned u32x4 __attribute__((ext_vector_type(4)));
typedef unsigned u32x2 __attribute__((ext_vector_type(2)));
typedef int i32x4 __attribute__((ext_vector_type(4)));
typedef int i32x8 __attribute__((ext_vector_type(8)));

constexpr int NB = 4, SEQ = 8192, D = 1024, NTOK = NB * SEQ;
constexpr int GD = 2048;
constexpr int NEXP = 32, TOPK = 4, NASG = NTOK * TOPK;
constexpr int PLE = 256;
constexpr int NKVG = 4, HD = 64, NHEAD = 16;
constexpr int NCMP = 511, NCMPP = 512, NSEL = 128;
constexpr float EPS = 1e-6f;
constexpr int NKVQ = 2816;
constexpr int ACT_ROWS = NASG + NEXP * 256;

constexpr size_t MiB = 1u << 20;
constexpr size_t WS_CTL = 0, CTL_ZERO_BYTES = 1 * MiB;
constexpr size_t WS_SSQ1 = 1 * MiB;
constexpr size_t WS_SSQ16 = 2 * MiB;
constexpr size_t WS_LNP = 8 * MiB;
constexpr size_t WS_WAIN = 16 * MiB;
constexpr size_t WS_WAOUT = 24 * MiB;
constexpr size_t WS_WKVQ = 28 * MiB;
constexpr size_t WS_WO = 34 * MiB;
constexpr size_t WS_WPG = 36 * MiB;
constexpr size_t WS_WPL = 40 * MiB;
constexpr size_t WS_WC1 = 41 * MiB;
constexpr size_t WS_WAS = 43 * MiB;
constexpr size_t WS_CB1 = 43 * MiB + 512 * 1024;
constexpr size_t WS_WGU = 44 * MiB;
constexpr size_t WS_WD = 300 * MiB;
constexpr size_t WS_PB = 428 * MiB;
constexpr size_t WS_HF = 460 * MiB;
constexpr size_t WS_HB0 = 588 * MiB;
constexpr size_t WS_HB1 = 652 * MiB;
constexpr size_t WS_U = 716 * MiB;
constexpr size_t WS_V = 844 * MiB;
constexpr size_t WS_ACT = 972 * MiB;
constexpr size_t WS_Y = 1244 * MiB;
constexpr size_t WS_PW = 1500 * MiB;
constexpr size_t WS_KSEL = 1628 * MiB;
constexpr size_t WS_KWIN = 1644 * MiB;
constexpr size_t WS_KC = 1660 * MiB;
constexpr size_t WS_VC = 1678 * MiB;
constexpr size_t WS_VSEL = 1696 * MiB;
constexpr size_t WS_VWIN = 1712 * MiB;
constexpr size_t WS_VTSEL = 1728 * MiB;
constexpr size_t WS_VTWIN = 1744 * MiB;
constexpr size_t WS_Q = 1760 * MiB;
constexpr size_t WS_GATES = 1824 * MiB;
constexpr size_t WS_HID = 1830 * MiB;
constexpr size_t WS_KCMP = 1838 * MiB;
constexpr size_t WS_VTCMP = 1839 * MiB;
constexpr size_t WS_AO = 1840 * MiB;
constexpr size_t WS_LSLOT = 1904 * MiB;
constexpr size_t WS_LW = 1908 * MiB;
constexpr size_t WS_LRS = 1912 * MiB;
constexpr size_t WS_TRASH = 1916 * MiB;
constexpr size_t WS_HQ = 1917 * MiB;
constexpr size_t WS_HQ2 = 1949 * MiB;
constexpr size_t WS_HQ3 = 1981 * MiB;
constexpr size_t WS_AOQ = 2013 * MiB;
constexpr size_t WS_END = 2045 * MiB;

constexpr int CW_BAR = 4096;
constexpr int CW_CNT = 32768;

constexpr int LDS_BYTES = 163840;
constexpr int LDS_STAGE = 0;
constexpr int LDS_AUX = 131072;
constexpr int LDS_MISC = LDS_BYTES - 256;

constexpr int NWAVES = 8, NTHR = 512;

__device__ __forceinline__ unsigned f2bf(float f) { unsigned u = __builtin_bit_cast(unsigned, f); return (u + 0x7fffu + ((u >> 16) & 1u)) >> 16; }
typedef __bf16 bf16x2_t __attribute__((ext_vector_type(2)));
__device__ __forceinline__ unsigned pk2(float lo, float hi) { const f32x2 v = {lo, hi}; return __builtin_bit_cast(unsigned, __builtin_convertvector(v, bf16x2_t)); }
__device__ __forceinline__ float bf2f(unsigned short b) { return __builtin_bit_cast(float, (unsigned)b << 16); }
__device__ __forceinline__ float bflo(unsigned w) { return __builtin_bit_cast(float, w << 16); }
__device__ __forceinline__ float bfhi(unsigned w) { return __builtin_bit_cast(float, w & 0xffff0000u); }
__device__ __forceinline__ unsigned pk4_fp8(float a, float b, float c, float d) { int r = 0; r = __builtin_amdgcn_cvt_pk_fp8_f32(a, b, r, false); r = __builtin_amdgcn_cvt_pk_fp8_f32(c, d, r, true); return (unsigned)r; }
constexpr float F8_SA = 8.0f, F8_SW = 256.0f, F8_SACT = 4.0f, F8_SY = 16.0f;
__device__ __forceinline__ int lane_id() { int l; asm volatile("v_mbcnt_lo_u32_b32 %0, -1, 0\n\tv_mbcnt_hi_u32_b32 %0, -1, %0" : "=v"(l)); return l; }
#define DPP_F(v, ctrl) __builtin_bit_cast(float, __builtin_amdgcn_update_dpp(0, __builtin_bit_cast(int, (v)), (ctrl), 0xF, 0xF, false))
__device__ __forceinline__ float wave_sum(float v) {
    v += DPP_F(v, 0xB1); v += DPP_F(v, 0x4E); v += DPP_F(v, 0x141); v += DPP_F(v, 0x140);
    return __builtin_bit_cast(float, __builtin_amdgcn_readlane(__builtin_bit_cast(int, v), 0)) + __builtin_bit_cast(float, __builtin_amdgcn_readlane(__builtin_bit_cast(int, v), 16))
         + (__builtin_bit_cast(float, __builtin_amdgcn_readlane(__builtin_bit_cast(int, v), 32)) + __builtin_bit_cast(float, __builtin_amdgcn_readlane(__builtin_bit_cast(int, v), 48)));
}
__device__ __forceinline__ float xsum16(float s) { float a = s, b = s; asm("s_nop 1\n\tv_permlane16_swap_b32 %0, %1" : "+v"(a), "+v"(b)); return a + b; }
__device__ __forceinline__ void swap16(unsigned& a, unsigned& b) { asm("s_nop 1\n\tv_permlane16_swap_b32 %0, %1" : "+v"(a), "+v"(b)); }
__device__ __forceinline__ float xsum32(float s) { float a = s, b = s; asm("s_nop 1\n\tv_permlane32_swap_b32 %0, %1" : "+v"(a), "+v"(b)); return a + b; }
__device__ __forceinline__ float fast_exp2(float x) { return __builtin_amdgcn_exp2f(x); }
__device__ __forceinline__ float fast_rcp(float x) { return __builtin_amdgcn_rcpf(x); }
__device__ __forceinline__ float sigmoidf_(float x) { return fast_rcp(1.0f + fast_exp2(-1.44269504089f * x)); }
__device__ __forceinline__ float gelu_tanh(float x) {
    const float t = x * (2.302208198f + 0.1029432397f * x * x);
    return x * fast_rcp(1.0f + fast_exp2(-t));
}
__device__ __forceinline__ f32x2 gelu_tanh2(f32x2 x) {
    const f32x2 p = __builtin_elementwise_fma(x * x, (f32x2){-0.1029432397f, -0.1029432397f}, (f32x2){-2.302208198f, -2.302208198f}), t = x * p;
    const f32x2 d = (f32x2){fast_exp2(t.x), fast_exp2(t.y)} + (f32x2){1.0f, 1.0f};
    return x * (f32x2){fast_rcp(d.x), fast_rcp(d.y)};
}
__device__ __forceinline__ float rstd_of(float ssq) { return __builtin_amdgcn_rsqf(ssq * (1.0f / D) + EPS); }
__device__ __forceinline__ float rstd16(const float* p) {
    const f32x4 a = *(const f32x4*)p, b = *(const f32x4*)(p + 4), c = *(const f32x4*)(p + 8), d = *(const f32x4*)(p + 12);
    const f32x4 s = (a + b) + (c + d);
    return rstd_of((s.x + s.y) + (s.z + s.w));
}

#define XB_TMO      128
#define XB_XCNT(j)  (256  + 64 * (j))
#define XB_XSUB(j)  (1280 + 64 * (j))
#define XB_XGEN(j)  (2304 + 64 * (j))
#define XB_TOP      3328
#define XB_TOPGEN   3392
#define XCD_BAR_WORDS 3456
#define XB_SPIN_CAP (1u << 18)
__device__ __forceinline__ unsigned xb_ld(unsigned* p)              { return __hip_atomic_load(p, __ATOMIC_RELAXED, __HIP_MEMORY_SCOPE_AGENT); }
__device__ __forceinline__ unsigned xb_add(unsigned* p, unsigned v) { return __hip_atomic_fetch_add(p, v, __ATOMIC_RELAXED, __HIP_MEMORY_SCOPE_AGENT); }
__device__ __forceinline__ unsigned xb_xcc_id() { return (unsigned)__builtin_amdgcn_s_getreg((3 << 11) | 20) & 0xFu; }
#define XB_SPIN(cond, bar) do { unsigned _sp = 0; while (cond) { __builtin_amdgcn_s_sleep(1); \
    if ((++_sp & 255u) == 0u) { if (xb_ld(&(bar)[XB_TMO])) break; if (_sp > XB_SPIN_CAP) { atomicAdd(&(bar)[XB_TMO], 1u); break; } } } } while (0)
struct XcdBarrier { unsigned* bar; unsigned x; volatile LAS unsigned* st; int wave; };
__device__ __forceinline__ XcdBarrier xcd_barrier_post(unsigned* bar, volatile LAS unsigned* st, int wave) {
    XcdBarrier b; b.bar = bar; b.x = xb_xcc_id(); b.st = st; b.wave = wave;
    if (wave == 0 && lane_id() == 0) (void)xb_add(&bar[XB_XCNT(b.x)], 1u);
    return b;
}
__device__ __forceinline__ void xcd_barrier_complete(unsigned* bar, unsigned x, unsigned& nloc, unsigned& nx) {
    const unsigned G = gridDim.x * gridDim.y * gridDim.z;
    unsigned sum, cnt, mine, sp = 0u;
    for (;;) {
        sum = 0u; cnt = 0u; mine = 0u;
#pragma unroll
        for (unsigned j = 0; j < 16; ++j) { const unsigned c = xb_ld(&bar[XB_XCNT(j)]); sum += c; cnt += (c > 0u) ? 1u : 0u; mine = (j == x) ? c : mine; }
        if (sum == G) break;
        __builtin_amdgcn_s_sleep(1);
        if ((++sp & 255u) == 0u) { if (xb_ld(&bar[XB_TMO])) break; if (sp > XB_SPIN_CAP) { atomicAdd(&bar[XB_TMO], 1u); break; } }
    }
    nloc = mine > 0u ? mine : 1u; nx = cnt > 0u ? cnt : 1u;
}
__device__ __forceinline__ void xcd_barrier(const XcdBarrier& b) {
    asm volatile("s_waitcnt vmcnt(0)" ::: "memory");
    __syncthreads();
    if (b.wave == 0 && lane_id() == 0) {
        unsigned* bar = b.bar;
        __builtin_amdgcn_s_waitcnt(0);
        unsigned nloc = b.st[0], nx = b.st[1];
        if (nloc == 0u) { xcd_barrier_complete(bar, b.x, nloc, nx); b.st[0] = nloc; b.st[1] = nx; }
        const unsigned old = xb_add(&bar[XB_XSUB(b.x)], 1u);
        const unsigned gen = old / nloc;
        if (old + 1u == (gen + 1u) * nloc) {
            __builtin_amdgcn_fence(__ATOMIC_RELEASE, "agent");
            asm volatile("s_waitcnt vmcnt(0)" ::: "memory");
            const unsigned og = xb_add(&bar[XB_TOP], 1u);
            const unsigned tg = og / nx;
            if (og + 1u == (tg + 1u) * nx) xb_add(&bar[XB_TOPGEN], 1u);
            else XB_SPIN(xb_ld(&bar[XB_TOPGEN]) == tg, bar);
            __builtin_amdgcn_fence(__ATOMIC_ACQUIRE, "agent");
            xb_add(&bar[XB_XGEN(b.x)], 1u);
            asm volatile("s_waitcnt vmcnt(0)" ::: "memory");
        } else {
            XB_SPIN(xb_ld(&bar[XB_XGEN(b.x)]) == gen, bar);
            __builtin_amdgcn_fence(__ATOMIC_ACQUIRE, "agent");
            asm volatile("s_waitcnt vmcnt(0)" ::: "memory");
        }
    }
    __syncthreads();
}

namespace g8 {
constexpr int BM = 256, BK = 64, HALF = 128, HTB = HALF * BK * 2, STAGE_BYTES = 8 * HTB, NXCD = 8;
__device__ __forceinline__ int lds_byte(int r, int c) { const int st = (r >> 4) * 2 + (c >> 5), rr = r & 15, cc = c & 31, ob = rr * 64 + cc * 2; return st * 1024 + (ob ^ (((ob >> 9) & 1) << 5)); }
__device__ __forceinline__ void stage_rc(int b, int& R, int& C) { const int st = b / 1024, sb = b % 1024, swz = sb ^ (((sb >> 9) & 1) << 5); R = (st >> 1) * 16 + swz / 64; C = (st & 1) * 32 + (swz % 64) / 2; }
__host__ __device__ __forceinline__ int perm32(int rho) { const int n = rho >> 4, i = rho & 15; return 8 * (i >> 2) + 4 * n + (i & 3); }

struct Unit { int pm, pn, e, pos0, cnt; };

template <class Epi, class Sched, bool GATHER, bool F8 = false>
__device__ __forceinline__ void gemm_phase(LAS unsigned char* lds, const int K, const int lda, const Sched& S, const Epi& E, const int wid) {
    const int lane = lane_id(), tid = wid * 64 + lane, wr = wid >> 2, wc = wid & 3, fr = lane & 15, fq = lane >> 4;
    const int nt = K / BK;
    int Rr[2], Cc[2];
#pragma unroll
    for (int i = 0; i < 2; ++i) stage_rc(tid * 16 + i * 8192, Rr[i], Cc[i]);
    unsigned voB0, voA[2][2], voAn[2][2];
    voB0 = (unsigned)(Rr[0] * K + Cc[0]) * 2u; const unsigned voA0 = (unsigned)(Rr[0] * lda + Cc[0]) * 2u;
#pragma unroll
    for (int h = 0; h < 2; ++h)
#pragma unroll
        for (int i = 0; i < 2; ++i) { voA[h][i] = (unsigned)((h * HALF + Rr[i]) * lda + Cc[i]) * 2u; voAn[h][i] = voA[h][i]; }
    const size_t kstep = (size_t)(BK * 2);
    const unsigned ldsw = (unsigned)wid * 1024u;
    const int aoff = lds_byte(wr * 64 + fr, fq * 8), boff = lds_byte(wc * 32 + fr, fq * 8);
#define G8_SA(b, h) (((b) * 2 + (h)) * HTB)
#define G8_SB(b, h) ((4 + (b) * 2 + (h)) * HTB)
#define G8_UNI(p) ((const char*)(((unsigned long long)(unsigned)__builtin_amdgcn_readfirstlane((int)((unsigned long long)(p) >> 32)) << 32) | (unsigned)__builtin_amdgcn_readfirstlane((int)(unsigned long long)(p))))
#define G8_STAGE(bufoff, gbase, voff) do { const char* _ub = G8_UNI(gbase); _Pragma("unroll") for (int _i = 0; _i < 2; ++_i) \
        __builtin_amdgcn_global_load_lds((const unsigned*)(_ub + (voff)[_i]), (LAS unsigned*)(lds + (bufoff) + ldsw + _i * 8192), 16, 0, 0); } while (0)
#define G8_STAGEB(bufoff, gbase, h) do { const char* _ub = G8_UNI((const char*)(gbase) + (size_t)(h) * HALF * K * 2); _Pragma("unroll") for (int _i = 0; _i < 2; ++_i) \
        __builtin_amdgcn_global_load_lds((const unsigned*)(_ub + (size_t)_i * 64 * K * 2 + voB0), (LAS unsigned*)(lds + (bufoff) + ldsw + _i * 8192), 16, 0, 0); } while (0)
#define G8_STAGEA(bufoff, gbase, vo, h) do { if constexpr (GATHER) { G8_STAGE(bufoff, gbase, (vo)[h]); } else { const char* _ua = G8_UNI((const char*)(gbase) + (size_t)(h) * HALF * lda * 2); _Pragma("unroll") for (int _i = 0; _i < 2; ++_i) \
        __builtin_amdgcn_global_load_lds((const unsigned*)(_ua + (size_t)_i * 64 * lda * 2 + voA0), (LAS unsigned*)(lds + (bufoff) + ldsw + _i * 8192), 16, 0, 0); } } while (0)
#define G8_LDA(dst, b, h) do { _Pragma("unroll") for (int m = 0; m < 4; ++m) _Pragma("unroll") for (int k = 0; k < 2; ++k) dst[m][k] = *(const LAS bf16x8*)(lds + G8_SA(b, h) + aoff + m * 2048 + k * 1024); } while (0)
#define G8_LDB(dst, b, h) do { _Pragma("unroll") for (int n = 0; n < 2; ++n) _Pragma("unroll") for (int k = 0; k < 2; ++k) dst[n][k] = *(const LAS bf16x8*)(lds + G8_SB(b, h) + boff + n * 2048 + k * 1024); } while (0)
#define G8_CAT(x) __builtin_shufflevector(__builtin_bit_cast(i32x4, (x)[0]), __builtin_bit_cast(i32x4, (x)[1]), 0, 1, 2, 3, 4, 5, 6, 7)
#define G8_MMA(ai, bj, At, Bt) do { __builtin_amdgcn_s_setprio(1); _Pragma("unroll") for (int m = 0; m < 4; ++m) _Pragma("unroll") for (int n = 0; n < 2; ++n) { \
        if constexpr (F8) acc[ai][bj][m][n] = __builtin_amdgcn_mfma_scale_f32_16x16x128_f8f6f4(G8_CAT(Bt[n]), G8_CAT(At[m]), acc[ai][bj][m][n], 0, 0, 0, 0x7f7f7f7f, 0, 0x7f7f7f7f); \
        else { _Pragma("unroll") for (int k = 0; k < 2; ++k) acc[ai][bj][m][n] = __builtin_amdgcn_mfma_f32_16x16x32_bf16(Bt[n][k], At[m][k], acc[ai][bj][m][n], 0, 0, 0); } } __builtin_amdgcn_s_setprio(0); } while (0)
#define G8_WAIT_V(n) asm volatile("s_waitcnt vmcnt(" #n ")" ::: "memory")
#define G8_WAIT_L(n) asm volatile("s_waitcnt lgkmcnt(" #n ")" ::: "memory")
#define G8_BAR __builtin_amdgcn_s_barrier()
#define G8_SCHED __builtin_amdgcn_sched_barrier(0)
    Unit cur, nxt, nx2; int ui = 0;
    if (!S.next(0, cur)) return;
    bool has_next = S.next(1, nxt);
    if constexpr (GATHER) {
#pragma unroll
        for (int h = 0; h < 2; ++h)
#pragma unroll
            for (int i = 0; i < 2; ++i) { voA[h][i] = (unsigned)(S.row_off(cur, h * HALF + Rr[i]) + Cc[i] * 2); voAn[h][i] = has_next ? (unsigned)(S.row_off(nxt, h * HALF + Rr[i]) + Cc[i] * 2) : voA[h][i]; }
    }
    f32x4 acc[2][2][4][2];
#pragma unroll
    for (int a = 0; a < 2; ++a)
#pragma unroll
        for (int b = 0; b < 2; ++b)
#pragma unroll
            for (int m = 0; m < 4; ++m)
#pragma unroll
                for (int n = 0; n < 2; ++n) acc[a][b][m][n] = (f32x4){0.f, 0.f, 0.f, 0.f};
    bf16x8 At[4][2], B0[2][2], B1[2][2];
    const char* cA = S.a_ptr(cur); const char* cB = S.b_ptr(cur);
    G8_STAGEB(G8_SB(0, 0), cB, 0); G8_STAGEB(G8_SB(0, 1), cB, 1); G8_STAGEA(G8_SA(0, 0), cA, voA, 0); G8_STAGEA(G8_SA(0, 1), cA, voA, 1);
    if (wr == 1) G8_BAR;
    G8_WAIT_V(2); G8_BAR;
    G8_STAGEB(G8_SB(1, 0), cB + kstep, 0); G8_STAGEA(G8_SA(1, 0), cA + kstep, voA, 0); G8_STAGEB(G8_SB(1, 1), cB + kstep, 1);
    G8_WAIT_V(6); G8_BAR;
    for (;;) {
        const char* nA = has_next ? S.a_ptr(nxt) : cA; const char* nB = has_next ? S.b_ptr(nxt) : cB;
        for (int krep = 0; krep < PROBE_KREP; ++krep)
#pragma clang loop unroll(disable)
        for (int t = 0; t < nt; t += 2) {
            const bool last = (t == nt - 2); const bool lastrep = (krep == PROBE_KREP - 1);
            const char* a1 = cA + (size_t)(t + 1) * kstep;
            const char* a2 = last ? (lastrep ? nA : cA) : cA + (size_t)(t + 2) * kstep; const char* b2 = last ? (lastrep ? nB : cB) : cB + (size_t)(t + 2) * kstep;
            const char* a3 = a2 + kstep; const char* b3 = b2 + kstep;
            unsigned vx[2][2];
#pragma unroll
            for (int h = 0; h < 2; ++h)
#pragma unroll
                for (int i = 0; i < 2; ++i) vx[h][i] = (GATHER && last && lastrep) ? voAn[h][i] : voA[h][i];
            G8_LDB(B0, 0, 0); G8_LDB(B1, 0, 1); G8_SCHED; G8_LDA(At, 0, 0); G8_STAGEA(G8_SA(1, 1), a1, voA, 1);
            G8_WAIT_V(8); G8_WAIT_L(0); G8_BAR; G8_MMA(0, 0, At, B0); G8_MMA(0, 1, At, B1); G8_BAR; G8_SCHED;
            G8_LDA(At, 0, 1); G8_STAGEB(G8_SB(0, 0), b2, 0); G8_STAGEB(G8_SB(0, 1), b2, 1); G8_STAGEA(G8_SA(0, 0), a2, vx, 0);
            G8_WAIT_V(8); G8_WAIT_L(0); G8_BAR; G8_MMA(1, 0, At, B0); G8_MMA(1, 1, At, B1); G8_BAR; G8_SCHED;
            G8_LDB(B0, 1, 0); G8_LDB(B1, 1, 1); G8_SCHED; G8_LDA(At, 1, 0); G8_STAGEA(G8_SA(0, 1), a2, vx, 1);
            G8_WAIT_V(8); G8_WAIT_L(0); G8_BAR; G8_MMA(0, 0, At, B0); G8_MMA(0, 1, At, B1); G8_BAR; G8_SCHED;
            G8_LDA(At, 1, 1); G8_STAGEB(G8_SB(1, 0), b3, 0); G8_STAGEB(G8_SB(1, 1), b3, 1); G8_STAGEA(G8_SA(1, 0), a3, vx, 0);
            G8_WAIT_V(8); G8_WAIT_L(0); G8_BAR; G8_MMA(1, 0, At, B0); G8_MMA(1, 1, At, B1); G8_BAR; G8_SCHED;
        }
        if (wr == 0) G8_BAR;
        if (PROBE_KREP == 2) {
#pragma unroll
            for (int a = 0; a < 2; ++a)
#pragma unroll
                for (int b = 0; b < 2; ++b)
#pragma unroll
                    for (int m = 0; m < 4; ++m)
#pragma unroll
                        for (int n = 0; n < 2; ++n) acc[a][b][m][n] = acc[a][b][m][n] * 0.5f;
        }
        { const int l2 = lane_id(); E(acc, cur, wr, wc, l2 & 15, l2 >> 4); }
        if constexpr (F8 && PROBE_EREP) { asm volatile("" ::: "memory"); E(acc, cur, wr, wc, fr, fq); }
        if (!has_next) break;
        const bool has2 = S.next(ui + 2, nx2);
        if constexpr (GATHER) {
            int ro[2][2];
#pragma unroll
            for (int h = 0; h < 2; ++h)
#pragma unroll
                for (int i = 0; i < 2; ++i) ro[h][i] = S.row_off(has2 ? nx2 : nxt, h * HALF + Rr[i]);
#pragma unroll
            for (int h = 0; h < 2; ++h)
#pragma unroll
                for (int i = 0; i < 2; ++i) { voA[h][i] = voAn[h][i]; voAn[h][i] = (unsigned)(ro[h][i] + Cc[i] * 2); }
        }
#pragma unroll
        for (int a = 0; a < 2; ++a)
#pragma unroll
            for (int b = 0; b < 2; ++b)
#pragma unroll
                for (int m = 0; m < 4; ++m)
#pragma unroll
                    for (int n = 0; n < 2; ++n) acc[a][b][m][n] = (f32x4){0.f, 0.f, 0.f, 0.f};
        cur = nxt; cA = nA; cB = nB; ++ui; nxt = nx2; has_next = has2;
        if (wr == 1) G8_BAR;
    }
    G8_WAIT_V(0);
    G8_BAR;
#undef G8_SA
#undef G8_SB
#undef G8_STAGE
#undef G8_STAGEB
#undef G8_STAGEA
#undef G8_UNI
#undef G8_LDA
#undef G8_LDB
#undef G8_MMA
#undef G8_CAT
#undef G8_WAIT_V
#undef G8_WAIT_L
#undef G8_BAR
#undef G8_SCHED
}

struct StaticOrder {
    int nM, nN, nwg, G, c;
    __device__ void init(int nM_, int nN_, int G_, int c_) { nM = nM_; nN = nN_; nwg = nM * nN; G = G_; c = c_; }
    __device__ bool tile(int i, int& pm, int& pn) const {
        const long L = (long)i * G + c; if (L >= nwg) return false;
        int wgid = (int)L; { const int q = nwg / NXCD, r = nwg % NXCD, xcd = wgid % NXCD, off = wgid / NXCD; wgid = (xcd < r ? xcd * (q + 1) : r * (q + 1) + (xcd - r) * q) + off; }
        const int nig = 8 * nN, gid = wgid / nig, fm = gid * 8, gsz = (nM - fm) < 8 ? (nM - fm) : 8;
        pm = fm + ((wgid % nig) % gsz); pn = (wgid % nig) / gsz; return true;
    }
};
}
using g8::Unit;

struct Frame {
    LAS unsigned char* lds;
    unsigned* ctl;
    int wave, G, bx;
    int pw_done;
    unsigned char* ws;
    const float* const __attribute__((address_space(4)))* in;
    float* out;
};
enum { I_X = 0, I_P, I_RELB, I_NMIX, I_NFFN, I_AWIN, I_ALNG, I_ALNB, I_AWS, I_ABS, I_AWOUT, I_KVNORM, I_KVW, I_CMPPOS, I_CMPW1, I_CMPB1, I_CMPW2, I_KNORM,
       I_BWIN, I_BBGATE, I_QNORM, I_BWOUT, I_RW, I_RB, I_EWGU, I_EBGU, I_EWD, I_EBD, I_PLEW, I_PLEGW, I_PLENORM };

#define LDS_WAIT() asm volatile("s_waitcnt lgkmcnt(0)" ::: "memory")

struct ConvLd { f32x4 v[8]; };
__device__ __forceinline__ void conv_load(ConvLd& L, const float* W, int ldw, int ncols, int sc0, int kb, int lane) {
    const int k0 = 64 * kb, c4 = lane & 7, rr = lane >> 3; const bool ok = (sc0 + 4 * c4 + 3) < ncols;
#pragma unroll
    for (int i = 0; i < 8; ++i) L.v[i] = ok ? *(const f32x4*)(W + (size_t)(k0 + rr + 8 * i) * ldw + sc0 + 4 * c4) : (f32x4){0.f, 0.f, 0.f, 0.f};
}
template <bool F8> __device__ __forceinline__ void conv_store(const ConvLd& L, int K, const float* gain, bf16* WT, int db, int kb, LAS float* scr, int lane) {
    const int k0 = 64 * kb, c4 = lane & 7, rr = lane >> 3;
#pragma unroll
    for (int i = 0; i < 8; ++i) { const int kk = rr + 8 * i; const float gsc = gain ? gain[k0 + kk] : 1.0f; LAS float* p = scr + kk * 33 + 4 * c4;
        p[0] = L.v[i].x * gsc; p[1] = L.v[i].y * gsc; p[2] = L.v[i].z * gsc; p[3] = L.v[i].w * gsc; }
    LDS_WAIT(); asm volatile("" ::: "memory");
    const int c = lane & 7;
#pragma unroll
    for (int j = 0; j < 4; ++j) { const int rho = (lane >> 3) + 8 * j; const LAS float* s = scr + (8 * c) * 33 + g8::perm32(rho);
        if constexpr (F8) { u32x2 o; o.x = pk4_fp8(s[0 * 33] * F8_SW, s[1 * 33] * F8_SW, s[2 * 33] * F8_SW, s[3 * 33] * F8_SW); o.y = pk4_fp8(s[4 * 33] * F8_SW, s[5 * 33] * F8_SW, s[6 * 33] * F8_SW, s[7 * 33] * F8_SW);
            *(u32x2*)((unsigned char*)WT + (size_t)(32 * db + rho) * K + k0 + 8 * c) = o; }
        else { u32x4 o; o.x = pk2(s[0 * 33], s[1 * 33]); o.y = pk2(s[2 * 33], s[3 * 33]); o.z = pk2(s[4 * 33], s[5 * 33]); o.w = pk2(s[6 * 33], s[7 * 33]);
            *(u32x4*)(WT + (size_t)(32 * db + rho) * K + k0 + 8 * c) = o; } }
    LDS_WAIT(); asm volatile("" ::: "memory");
}
enum { MAP_ID = 0, MAP_HEAD = 1, MAP_GU = 2 };
template <int MAP> __device__ __forceinline__ int map_block(int db) {
    if (MAP == MAP_ID) return db;
    if (MAP == MAP_HEAD) { const int t = db >> 3, q = db & 7, bj = q >> 2, wc = q & 3; return t * 8 + 2 * wc + bj; }
    { const int pn = db >> 3, q = db & 7, bj = q >> 2, wc = q & 3; return bj * 32 + 4 * pn + wc; }
}
template <int MAP, bool F8 = false> __device__ __forceinline__ void conv_job(Frame& F, const float* W, size_t smat, int nmat, int K, int ldw, int ncols, int col0, const float* gain, int gstride, int gmat_div,
                                                          bf16* WT, size_t dmat, int ndb, LAS float* scr) {
    const int gw = F.bx * NWAVES + F.wave, NGW = F.G * NWAVES, lane = lane_id();
    const int nkb = K / 64, per = nkb * ndb, total = per * nmat;
    ConvLd q0, q1, q2, q3;
#define CV_LOAD(q, it_) do { const int _it = (it_); if (_it < total) { const int _m = _it / per, _r = _it % per; conv_load(q, W + (size_t)_m * smat, ldw, ncols, col0 + 32 * map_block<MAP>(_r % ndb), _r / ndb, lane); } } while (0)
#define CV_STORE(q, it_) do { const int _it = (it_); if (_it < total) { const int _m = _it / per, _r = _it % per; conv_store<F8>(q, K, gain ? gain + (size_t)(_m / gmat_div) * gstride : nullptr, WT + (size_t)_m * dmat, _r % ndb, _r / ndb, scr, lane); } } while (0)
    CV_LOAD(q0, gw); CV_LOAD(q1, gw + NGW); CV_LOAD(q2, gw + 2 * NGW);
    for (int it = gw; it < total; it += 4 * NGW) {
        CV_LOAD(q3, it + 3 * NGW); CV_STORE(q0, it);
        CV_LOAD(q0, it + 4 * NGW); CV_STORE(q1, it + NGW);
        CV_LOAD(q1, it + 5 * NGW); CV_STORE(q2, it + 2 * NGW);
        CV_LOAD(q2, it + 6 * NGW); CV_STORE(q3, it + 3 * NGW);
    }
#undef CV_LOAD
#undef CV_STORE
}
__device__ __forceinline__ void p0_prologue(Frame& F) {
    LAS float* scr = (LAS float*)(F.lds + LDS_STAGE + F.wave * 16384);
    unsigned char* ws = F.ws;
    const int gw = F.bx * NWAVES + F.wave, NGW = F.G * NWAVES;
    { const float* x = F.in[I_X]; bf16* hb = (bf16*)(ws + WS_HB0); float* ssq = (float*)(ws + WS_SSQ1);
      for (int m = gw; m < NTOK; m += NGW) {
          const f32x4* xr = (const f32x4*)(x + (size_t)m * D) + lane_id(); f32x4 v[4]; float s = 0.f;
#pragma unroll
          for (int j = 0; j < 4; ++j) { v[j] = xr[64 * j]; s += (v[j].x * v[j].x + v[j].y * v[j].y) + (v[j].z * v[j].z + v[j].w * v[j].w); }
          s = wave_sum(s);
          u32x2* o8 = (u32x2*)(hb + (size_t)m * D) + lane_id();
#pragma unroll
          for (int j = 0; j < 4; ++j) { u32x2 w; w.x = pk2(v[j].x, v[j].y); w.y = pk2(v[j].z, v[j].w); o8[64 * j] = w; }
          if (lane_id() == 0) ssq[m] = s;
      } }
    { unsigned long long* z = (unsigned long long*)(ws + WS_SSQ1 + 512 * 1024); for (int i = F.bx * NTHR + (F.wave * 64 + lane_id()); i < NTOK; i += F.G * NTHR) z[i] = 0ull; }
    { const f32x4* p = (const f32x4*)F.in[I_P]; u32x2* pb = (u32x2*)(ws + WS_PB); const size_t n4 = (size_t)2 * NTOK * PLE / 4;
      for (size_t i = (size_t)F.bx * NTHR + (F.wave * 64 + lane_id()); i < n4; i += (size_t)F.G * NTHR) { const f32x4 v = p[i]; u32x2 w; w.x = pk2(v.x, v.y); w.y = pk2(v.z, v.w); pb[i] = w; } }
    { const float* wsp = F.in[I_AWS]; bf16* o = (bf16*)(ws + WS_WAS);
      for (int i = F.bx * NTHR + (F.wave * 64 + lane_id()); i < 8 * 128 * 128; i += F.G * NTHR) { const int t = (i >> 7) & 127, s = i & 127; o[i] = (bf16)f2bf(s <= t ? wsp[i] : 0.f); } }
    { float* cb = (float*)(ws + WS_CB1);
      for (int o = gw; o < 2 * 256; o += NGW) { const int j = o >> 8, f = o & 255; const float* pos = F.in[I_CMPPOS] + (size_t)j * 2048; const float* w1 = F.in[I_CMPW1] + (size_t)j * 2048 * 256 + f;
          float s = 0.f; for (int k = lane_id(); k < 2048; k += 64) s += pos[k] * w1[(size_t)k * 256];
          s = wave_sum(s); if (lane_id() == 0) cb[o] = s + F.in[I_CMPB1][o]; } }
    conv_job<MAP_ID>(F, F.in[I_AWIN], 0, 1, D, 4096, 4096, 0, F.in[I_NMIX], 0, 1, (bf16*)(ws + WS_WAIN), 0, 128, scr);
    conv_job<MAP_ID>(F, F.in[I_AWOUT], 0, 1, GD, D, D, 0, nullptr, 0, 1, (bf16*)(ws + WS_WAOUT), 0, 32, scr);
    conv_job<MAP_HEAD, true>(F, F.in[I_KVW], 0, 1, D, 1536, 1536, 0, F.in[I_KVNORM], 0, 1, (bf16*)(ws + WS_WKVQ), 0, 48, scr);
    conv_job<MAP_HEAD, true>(F, F.in[I_BWIN], 0, 1, D, 1072, 1024, 0, F.in[I_NMIX] + D, 0, 1, (bf16*)(ws + WS_WKVQ + (size_t)1536 * D), 0, 32, scr);
    conv_job<MAP_ID, true>(F, F.in[I_BWIN], 0, 1, D, 1072, 1072, 1024, F.in[I_NMIX] + D, 0, 1, (bf16*)(ws + WS_WKVQ + (size_t)2560 * D), 0, 8, scr);
    conv_job<MAP_ID, true>(F, F.in[I_BWOUT], 0, 1, D, D, D, 0, nullptr, 0, 1, (bf16*)(ws + WS_WO), 0, 32, scr);
    conv_job<MAP_ID, true>(F, F.in[I_PLEGW], (size_t)D * D, 2, D, D, D, 0, F.in[I_PLENORM], D, 1, (bf16*)(ws + WS_WPG), (size_t)D * D / 2, 32, scr);
    conv_job<MAP_ID>(F, F.in[I_PLEW], (size_t)PLE * D, 2, PLE, D, D, 0, nullptr, 0, 1, (bf16*)(ws + WS_WPL), (size_t)D * PLE, 32, scr);
    conv_job<MAP_ID>(F, F.in[I_CMPW1], (size_t)2048 * 256, 2, 2048, 256, 256, 0, nullptr, 0, 1, (bf16*)(ws + WS_WC1), (size_t)256 * 2048, 8, scr);
    conv_job<MAP_GU, true>(F, F.in[I_EWGU], (size_t)D * 2048, 32, D, 2048, 2048, 0, F.in[I_NFFN], D, 32, (bf16*)(ws + WS_WGU), (size_t)2048 * D / 2, 64, scr);
    conv_job<MAP_ID, true>(F, F.in[I_EWD], (size_t)D * D, 32, D, D, D, 0, nullptr, 0, 1, (bf16*)(ws + WS_WD), (size_t)D * D / 2, 32, scr);
}

__device__ __forceinline__ void conv_l1_slice(Frame& F, const int k, LAS float* scr) {
    const int gw = F.bx * NWAVES + F.wave, NGW = F.G * NWAVES, lane = lane_id();
    const int dit = k * NGW + gw; if (dit >= 16384) return;
    unsigned char* ws = F.ws;
    const float* Wg = F.in[I_EWGU] + (size_t)32 * D * 2048; const float* Wd = F.in[I_EWD] + (size_t)32 * D * D; const float* gain = F.in[I_NFFN] + D;
    bf16* Tg = (bf16*)(ws + WS_WGU) + (size_t)32 * (2048 * D / 2); bf16* Td = (bf16*)(ws + WS_WD) + (size_t)32 * (D * D / 2);
    ConvLd q0, q1, q2;
    const int g0 = 2 * dit, g1 = g0 + 1, m0 = g0 >> 10, r0 = g0 & 1023, m1 = g1 >> 10, r1 = g1 & 1023, md = dit >> 9, rd = dit & 511;
    conv_load(q0, Wg + (size_t)m0 * D * 2048, 2048, 2048, 32 * map_block<MAP_GU>(r0 & 63), r0 >> 6, lane);
    conv_load(q1, Wg + (size_t)m1 * D * 2048, 2048, 2048, 32 * map_block<MAP_GU>(r1 & 63), r1 >> 6, lane);
    conv_load(q2, Wd + (size_t)md * D * D, D, D, 32 * map_block<MAP_ID>(rd & 31), rd >> 5, lane);
    conv_store<true>(q0, D, gain, Tg + (size_t)m0 * (2048 * D / 2), r0 & 63, r0 >> 6, scr, lane);
    conv_store<true>(q1, D, gain, Tg + (size_t)m1 * (2048 * D / 2), r1 & 63, r1 >> 6, scr, lane);
    conv_store<true>(q2, D, nullptr, Td + (size_t)md * (D * D / 2), rd & 31, rd >> 5, scr, lane);
}

struct SchedPlain {
    g8::StaticOrder so; const bf16* A; const bf16* Bt; int lda, K;
    __device__ __forceinline__ bool next(int i, Unit& u) const { u.e = 0; u.pos0 = 0; u.cnt = 0; return so.tile(i, u.pm, u.pn); }
    __device__ __forceinline__ const char* a_ptr(const Unit& u) const { return (const char*)(A + (size_t)u.pm * 256 * lda); }
    __device__ __forceinline__ const char* b_ptr(const Unit& u) const { return (const char*)(Bt + (size_t)u.pn * 256 * K); }
    __device__ __forceinline__ int row_off(const Unit&, int) const { return 0; }
};
struct SchedPair {
    g8::StaticOrder so; const bf16* A0; const bf16* A1; const bf16* B0; const bf16* B1; int lda, K, nMh;
    __device__ __forceinline__ bool next(int i, Unit& u) const { u.pos0 = 0; u.cnt = 0; const bool ok = so.tile(i, u.pm, u.pn); u.e = ok ? (u.pm >= nMh ? 1 : 0) : 0; return ok; }
    __device__ __forceinline__ const char* a_ptr(const Unit& u) const { return (const char*)((u.e ? A1 : A0) + (size_t)(u.pm - u.e * nMh) * 256 * lda); }
    __device__ __forceinline__ const char* b_ptr(const Unit& u) const { return (const char*)((u.e ? B1 : B0) + (size_t)u.pn * 256 * K); }
    __device__ __forceinline__ int row_off(const Unit&, int) const { return 0; }
};
struct SchedPw {
    int first, stride, count, limit; const bf16* A0; const bf16* B0;
    __device__ __forceinline__ bool next(int i, Unit& u) const { u.pos0 = 0; u.cnt = 0; const int t = first + i * stride; const bool ok = i < count && t < limit; u.pm = ok ? t >> 2 : 0; u.pn = ok ? t & 3 : 0; u.e = u.pm >= NTOK / 256 ? 1 : 0; return ok; }
    __device__ __forceinline__ const char* a_ptr(const Unit& u) const { return (const char*)(A0 + (size_t)u.pm * 256 * PLE); }
    __device__ __forceinline__ const char* b_ptr(const Unit& u) const { return (const char*)(B0 + ((size_t)u.e * D + (size_t)u.pn * 256) * PLE); }
    __device__ __forceinline__ int row_off(const Unit&, int) const { return 0; }
};
struct MoeTab { LAS int* tile_e; LAS int* tile0; LAS int* cnt; int ntile; };
__device__ __forceinline__ MoeTab moe_build_tab(Frame& F, int layer) {
    MoeTab T; T.tile_e = (LAS int*)(F.lds + LDS_AUX); T.tile0 = T.tile_e + 640; T.cnt = T.tile0 + 64;
    LAS int* ntile = T.cnt + 64;
    __syncthreads();
    if ((F.wave * 64 + lane_id()) < 32) T.cnt[(F.wave * 64 + lane_id())] = (int)__hip_atomic_load(F.ctl + CW_CNT + (layer * 32 + (F.wave * 64 + lane_id())) * 64, __ATOMIC_RELAXED, __HIP_MEMORY_SCOPE_AGENT);
    __syncthreads();
    if ((F.wave * 64 + lane_id()) == 0) { int t = 0; for (int e = 0; e < 32; ++e) { T.tile0[e] = t; t += (T.cnt[e] + 255) >> 8; } T.tile0[32] = t; *ntile = t; }
    __syncthreads();
    for (int t = F.wave * 64 + lane_id(); t < *ntile; t += NTHR) { int e = 0;
#pragma unroll
        for (int k = 1; k < 32; ++k) e += (T.tile0[k] <= t) ? 1 : 0;
        T.tile_e[t] = e; }
    __syncthreads();
    T.ntile = __builtin_amdgcn_readfirstlane(*ntile);
    return T;
}
template <int NN, int GM>
struct SchedMoe {
    MoeTab T; int G, c, nU; const char* A; const char* W; const int* lslot; int gather; size_t wstride; int rowb;
    __device__ __forceinline__ void init(const MoeTab& T_, int G_, int c_) { T = T_; G = G_; c = c_; nU = T.ntile * NN; }
    __device__ __forceinline__ bool next(int i, Unit& u) const {
        const long L = (long)i * G + c; if (L >= nU) return false;
        int w = (int)L; { const int q = nU / 8, r = nU % 8, xcd = w % 8, off = w / 8; w = (xcd < r ? xcd * (q + 1) : r * (q + 1) + (xcd - r) * q) + off; }
        const int gsz = GM * NN, gid = w / gsz, fm = gid * GM, rem = T.ntile - fm, gm = rem < GM ? rem : GM, r2 = w % gsz;
        u.pm = fm + r2 % gm; u.pn = r2 / gm;
        const int e = __builtin_amdgcn_readfirstlane(T.tile_e[u.pm]); u.e = e; u.pos0 = (u.pm - __builtin_amdgcn_readfirstlane(T.tile0[e])) * 256; u.cnt = __builtin_amdgcn_readfirstlane(T.cnt[e]);
        return true;
    }
    __device__ __forceinline__ const char* a_ptr(const Unit& u) const { return gather ? A : A + (size_t)u.pm * 256 * rowb; }
    __device__ __forceinline__ const char* b_ptr(const Unit& u) const { return W + (size_t)u.e * wstride + (size_t)u.pn * 256 * rowb; }
    __device__ __forceinline__ int row_off(const Unit& u, int r) const { int pos = u.pos0 + r; pos = pos < u.cnt ? pos : u.cnt - 1; return (lslot[(size_t)u.e * NTOK + pos] >> 2) * rowb; }
};

#define EPI_ROWS(ai, m) (128 * (ai) + 64 * wr + 16 * (m) + fr)
#define EPI_COL(bj) (128 * (bj) + 32 * wc + 8 * fq)
__device__ __forceinline__ u32x4 pack8(const f32x4& a, const f32x4& b) { u32x4 w; w.x = pk2(a.x, a.y); w.y = pk2(a.z, a.w); w.z = pk2(b.x, b.y); w.w = pk2(b.z, b.w); return w; }
__device__ __forceinline__ float sq4(const f32x4& a) { return (a.x * a.x + a.y * a.y) + (a.z * a.z + a.w * a.w); }
__device__ __forceinline__ float sum4(const f32x4& a) { return (a.x + a.y) + (a.z + a.w); }

struct EpiGelu {
    bf16* U; bf16* V; const float* ssq; float* lnp;
    __device__ __forceinline__ void operator()(const f32x4 (&acc)[2][2][4][2], const Unit& u, int wr, int wc, int fr, int fq) const {
        const bool isv = u.pn >= 8; bf16* base = isv ? V : U; const int ct = (isv ? u.pn - 8 : u.pn) * 256;
        float rsv[2][4];
#pragma unroll
        for (int ai = 0; ai < 2; ++ai)
#pragma unroll
            for (int m = 0; m < 4; ++m) rsv[ai][m] = ssq[u.pm * 256 + EPI_ROWS(ai, m)];
#pragma unroll
        for (int ai = 0; ai < 2; ++ai)
#pragma unroll
            for (int m = 0; m < 4; ++m) { const int row = u.pm * 256 + EPI_ROWS(ai, m); const float rs = rstd_of(rsv[ai][m]); float s1 = 0.f, s2 = 0.f;
#pragma unroll
                for (int bj = 0; bj < 2; ++bj) { f32x4 v0 = acc[ai][bj][m][0] * rs, v1 = acc[ai][bj][m][1] * rs;
                    { const f32x2 a = gelu_tanh2((f32x2){v0.x, v0.y}), b = gelu_tanh2((f32x2){v0.z, v0.w}), c = gelu_tanh2((f32x2){v1.x, v1.y}), d = gelu_tanh2((f32x2){v1.z, v1.w});
                      v0 = (f32x4){a.x, a.y, b.x, b.y}; v1 = (f32x4){c.x, c.y, d.x, d.y}; }
                    *(u32x4*)(base + (size_t)row * GD + ct + EPI_COL(bj)) = pack8(v0, v1);
                    s1 += sum4(v0) + sum4(v1); s2 += sq4(v0) + sq4(v1); }
                if (isv) { s1 = xsum32(xsum16(s1)); s2 = xsum32(xsum16(s2));
                    if (fq == 0) *(f32x2*)(lnp + ((size_t)row * 32 + (u.pn - 8) * 4 + wc) * 2) = (f32x2){s1, s2}; } }
    }
};
template <bool BASE16> struct EpiResid {
    const void* base; bf16* hf; unsigned char* hq; float sc;
    __device__ __forceinline__ void operator()(const f32x4 (&acc)[2][2][4][2], const Unit& u, int wr, int wc, int fr, int fq) const {
#pragma unroll
        for (int ai = 0; ai < 2; ++ai) {
            f32x4 pre[4][2][2];
#pragma unroll
            for (int m = 0; m < 4; ++m)
#pragma unroll
                for (int bj = 0; bj < 2; ++bj) { const size_t o = (size_t)(u.pm * 256 + EPI_ROWS(ai, m)) * D + u.pn * 256 + EPI_COL(bj);
                    if constexpr (BASE16) { const u32x4 w = *(const u32x4*)((const bf16*)base + o); pre[m][bj][0] = (f32x4){bflo(w.x), bfhi(w.x), bflo(w.y), bfhi(w.y)}; pre[m][bj][1] = (f32x4){bflo(w.z), bfhi(w.z), bflo(w.w), bfhi(w.w)}; }
                    else { pre[m][bj][0] = *(const f32x4*)((const float*)base + o); pre[m][bj][1] = *(const f32x4*)((const float*)base + o + 4); } }
#pragma unroll
            for (int m = 0; m < 4; ++m)
#pragma unroll
                for (int bj = 0; bj < 2; ++bj) { const size_t o = (size_t)(u.pm * 256 + EPI_ROWS(ai, m)) * D + u.pn * 256 + EPI_COL(bj);
                    const f32x4 h0 = pre[m][bj][0] + acc[ai][bj][m][0] * sc, h1 = pre[m][bj][1] + acc[ai][bj][m][1] * sc;
                    *(u32x4*)(hf + o) = pack8(h0, h1);
                    const f32x4 q0 = h0 * F8_SA, q1 = h1 * F8_SA; *(u32x2*)(hq + o) = (u32x2){pk4_fp8(q0.x, q0.y, q0.z, q0.w), pk4_fp8(q1.x, q1.y, q1.z, q1.w)}; }
        }
    }
};
struct EpiPw {
    bf16* pw;
    __device__ __forceinline__ void operator()(const f32x4 (&acc)[2][2][4][2], const Unit& u, int wr, int wc, int fr, int fq) const {
#pragma unroll
        for (int ai = 0; ai < 2; ++ai)
#pragma unroll
            for (int m = 0; m < 4; ++m) { const int row = u.pm * 256 + EPI_ROWS(ai, m);
#pragma unroll
                for (int bj = 0; bj < 2; ++bj) *(u32x4*)(pw + (size_t)row * D + u.pn * 256 + EPI_COL(bj)) = pack8(acc[ai][bj][m][0], acc[ai][bj][m][1]); }
    }
};
template <bool FINAL> struct EpiPle {
    bf16* hr; const bf16* pw; const float* ssq1; unsigned char* hq; unsigned long long* ssq_out; float* out;
    __device__ __forceinline__ void operator()(const f32x4 (&acc)[2][2][4][2], const Unit& u, int wr, int wc, int fr, int fq) const {
        float rsv[2][4];
#pragma unroll
        for (int ai = 0; ai < 2; ++ai)
#pragma unroll
            for (int m = 0; m < 4; ++m) rsv[ai][m] = ssq1[u.pm * 256 + EPI_ROWS(ai, m)];
#pragma unroll
        for (int ai = 0; ai < 2; ++ai)
#pragma unroll
            for (int mp = 0; mp < 2; ++mp) {
            u32x4 ph[2][2], pp[2][2];
#pragma unroll
            for (int mm = 0; mm < 2; ++mm)
#pragma unroll
                for (int bj = 0; bj < 2; ++bj) { const size_t o = (size_t)(u.pm * 256 + EPI_ROWS(ai, 2 * mp + mm)) * D + u.pn * 256 + EPI_COL(bj); ph[mm][bj] = *(const u32x4*)(hr + o); pp[mm][bj] = *(const u32x4*)(pw + o); }
#pragma unroll
            for (int mm = 0; mm < 2; ++mm) { const int m = 2 * mp + mm, row = u.pm * 256 + EPI_ROWS(ai, m); const float rs = rstd_of(rsv[ai][m]) * (1.0f / (F8_SA * F8_SW)); float ss = 0.f;
#pragma unroll
                for (int bj = 0; bj < 2; ++bj) { const size_t o = (size_t)row * D + u.pn * 256 + EPI_COL(bj);
                    const u32x4 pv = pp[mm][bj], hv = ph[mm][bj]; f32x4 h0 = {bflo(hv.x), bfhi(hv.x), bflo(hv.y), bfhi(hv.y)}, h1 = {bflo(hv.z), bfhi(hv.z), bflo(hv.w), bfhi(hv.w)};
                    const f32x4 g0 = acc[ai][bj][m][0] * rs, g1 = acc[ai][bj][m][1] * rs;
                    h0.x += bflo(pv.x) * sigmoidf_(g0.x); h0.y += bfhi(pv.x) * sigmoidf_(g0.y); h0.z += bflo(pv.y) * sigmoidf_(g0.z); h0.w += bfhi(pv.y) * sigmoidf_(g0.w);
                    h1.x += bflo(pv.z) * sigmoidf_(g1.x); h1.y += bfhi(pv.z) * sigmoidf_(g1.y); h1.z += bflo(pv.w) * sigmoidf_(g1.z); h1.w += bfhi(pv.w) * sigmoidf_(g1.w);
                    if (FINAL) { *(f32x4*)(out + o) = h0; *(f32x4*)(out + o + 4) = h1; }
                    else { *(u32x4*)(hr + o) = pack8(h0, h1); const f32x4 q0 = h0 * F8_SA, q1 = h1 * F8_SA; *(u32x2*)(hq + o) = (u32x2){pk4_fp8(q0.x, q0.y, q0.z, q0.w), pk4_fp8(q1.x, q1.y, q1.z, q1.w)}; ss += sq4(h0) + sq4(h1); } }
                if (!FINAL) { ss = xsum32(xsum16(ss)); if (fq == 0) atomicAdd(ssq_out + row, (unsigned long long)(ss * 1048576.0f)); } }
        }
    }
};
struct EpiMoe1 {
    unsigned char* act; const float* bgu; const float* lrs;
    __device__ __forceinline__ void operator()(const f32x4 (&acc)[2][2][4][2], const Unit& u, int wr, int wc, int fr, int fq) const {
        const int j0 = u.pn * 128 + 32 * wc + 8 * fq; const float* bg = bgu + (size_t)u.e * 2048 + j0;
        float rsv[2][4];
#pragma unroll
        for (int ai = 0; ai < 2; ++ai)
#pragma unroll
            for (int m = 0; m < 4; ++m) { int pos = u.pos0 + EPI_ROWS(ai, m); pos = pos < u.cnt ? pos : u.cnt - 1; rsv[ai][m] = lrs[(size_t)u.e * NTOK + pos] * (1.0f / (F8_SA * F8_SW)); }
        const f32x4 bg0 = *(const f32x4*)bg, bg1 = *(const f32x4*)(bg + 4), bu0 = *(const f32x4*)(bg + 1024), bu1 = *(const f32x4*)(bg + 1028);
        const int odd = fq & 1;
#pragma unroll
        for (int ai = 0; ai < 2; ++ai)
#pragma unroll
            for (int mp = 0; mp < 2; ++mp) { u32x2 pk[2];
#pragma unroll
                for (int mm = 0; mm < 2; ++mm) { const int m = 2 * mp + mm; const f32x2 rs = {rsv[ai][m], rsv[ai][m]};
                    f32x2 a[4];
#pragma unroll
                    for (int p = 0; p < 4; ++p) { const f32x4 cg = acc[ai][0][m][p >> 1], cu = acc[ai][1][m][p >> 1], vbg = (p >> 1) ? bg1 : bg0, vbu = (p >> 1) ? bu1 : bu0;
                        const f32x2 ag = (p & 1) ? (f32x2){cg.z, cg.w} : (f32x2){cg.x, cg.y}, au = (p & 1) ? (f32x2){cu.z, cu.w} : (f32x2){cu.x, cu.y};
                        const f32x2 pbg = (p & 1) ? (f32x2){vbg.z, vbg.w} : (f32x2){vbg.x, vbg.y}, pbu = (p & 1) ? (f32x2){vbu.z, vbu.w} : (f32x2){vbu.x, vbu.y};
                        f32x2 g = __builtin_elementwise_fma(ag, rs, pbg), up = __builtin_elementwise_fma(au, rs, pbu);
                        g.x = fminf(g.x, 7.0f); g.y = fminf(g.y, 7.0f); up.x = __builtin_amdgcn_fmed3f(up.x, -7.0f, 7.0f); up.y = __builtin_amdgcn_fmed3f(up.y, -7.0f, 7.0f);
                        const f32x2 t = g * (f32x2){-1.702f * 1.44269504089f, -1.702f * 1.44269504089f};
                        const f32x2 d = (f32x2){fast_exp2(t.x), fast_exp2(t.y)} + (f32x2){1.0f, 1.0f};
                        const f32x2 rr = {fast_rcp(d.x), fast_rcp(d.y)};
                        a[p] = __builtin_elementwise_fma(up, (f32x2){F8_SACT, F8_SACT}, (f32x2){F8_SACT, F8_SACT}) * (g * rr); }
                    pk[mm] = (u32x2){pk4_fp8(a[0].x, a[0].y, a[1].x, a[1].y), pk4_fp8(a[2].x, a[2].y, a[3].x, a[3].y)}; }
                unsigned x0 = pk[0].x, x1 = pk[0].y, y0 = pk[1].x, y1 = pk[1].y; swap16(x0, y0); swap16(x1, y1);
                *(u32x4*)(act + (size_t)(u.pm * 256 + EPI_ROWS(ai, 2 * mp) + 16 * odd) * D + j0 - 8 * odd) = (u32x4){x0, x1, y0, y1}; }
    }
};
struct EpiMoe2 {
    unsigned char* y; const float* bd; const int* lslot; const float* lw; unsigned char* trash;
    __device__ __forceinline__ void operator()(const f32x4 (&acc)[2][2][4][2], const Unit& u, int wr, int wc, int fr, int fq) const {
        f32x4 b[2][2];
#pragma unroll
        for (int bj = 0; bj < 2; ++bj) { const float* bp = bd + (size_t)u.e * D + u.pn * 256 + EPI_COL(bj); b[bj][0] = *(const f32x4*)bp; b[bj][1] = *(const f32x4*)(bp + 4); }
        int slv[2][4]; float wv[2][4];
#pragma unroll
        for (int ai = 0; ai < 2; ++ai)
#pragma unroll
            for (int m = 0; m < 4; ++m) { int pos = u.pos0 + EPI_ROWS(ai, m); pos = pos < u.cnt ? pos : u.cnt - 1; slv[ai][m] = lslot[(size_t)u.e * NTOK + pos]; wv[ai][m] = lw[(size_t)u.e * NTOK + pos]; }
        const int odd = fq & 1;
#pragma unroll
        for (int ai = 0; ai < 2; ++ai)
#pragma unroll
            for (int mp = 0; mp < 2; ++mp) { const int m0 = 2 * mp, m1 = m0 + 1;
                const bool ok0 = (u.pos0 + EPI_ROWS(ai, m0)) < u.cnt, ok1 = (u.pos0 + EPI_ROWS(ai, m1)) < u.cnt;
                unsigned char* rp0 = ok0 ? y + (size_t)slv[ai][m0] * D + u.pn * 256 : trash; unsigned char* rp1 = ok1 ? y + (size_t)slv[ai][m1] * D + u.pn * 256 : trash;
                unsigned char* rp = (odd ? rp1 : rp0) - 8 * odd;
                const float ws0 = wv[ai][m0] * F8_SY, ws1 = wv[ai][m1] * F8_SY;
#pragma unroll
                for (int bj = 0; bj < 2; ++bj) {
                    const f32x4 x0 = (acc[ai][bj][m0][0] * (1.0f / (F8_SACT * F8_SW)) + b[bj][0]) * ws0, x1 = (acc[ai][bj][m0][1] * (1.0f / (F8_SACT * F8_SW)) + b[bj][1]) * ws0;
                    const f32x4 y0 = (acc[ai][bj][m1][0] * (1.0f / (F8_SACT * F8_SW)) + b[bj][0]) * ws1, y1 = (acc[ai][bj][m1][1] * (1.0f / (F8_SACT * F8_SW)) + b[bj][1]) * ws1;
                    unsigned Xa = pk4_fp8(x0.x, x0.y, x0.z, x0.w), Xb = pk4_fp8(x1.x, x1.y, x1.z, x1.w), Ya = pk4_fp8(y0.x, y0.y, y0.z, y0.w), Yb = pk4_fp8(y1.x, y1.y, y1.z, y1.w);
                    swap16(Xa, Ya); swap16(Xb, Yb);
                    *(u32x4*)(rp + EPI_COL(bj)) = (u32x4){Xa, Xb, Ya, Yb}; } }
    }
};
struct EpiKvq {
    const unsigned long long* ssq;   bf16 *kc, *vc, *ksel, *vsel, *kwin, *vwin; bf16* q; float* gates; const float* knorm; const float* qnorm; const float* bgate;
    __device__ __forceinline__ void operator()(const f32x4 (&acc)[2][2][4][2], const Unit& u, int wr, int wc, int fr, int fq) const {
        const int pn = u.pn;
        if (pn == 10) {
            if (wc < 2) {
                float bgv[2][4]; unsigned long long rg[2][4];
#pragma unroll
                for (int n = 0; n < 2; ++n)
#pragma unroll
                    for (int j = 0; j < 4; ++j) { const int c = 32 * wc + 8 * fq + 4 * n + j; bgv[n][j] = bgate[c < 48 ? c : 47]; }
#pragma unroll
                for (int ai = 0; ai < 2; ++ai)
#pragma unroll
                    for (int m = 0; m < 4; ++m) rg[ai][m] = ssq[u.pm * 256 + EPI_ROWS(ai, m)];
#pragma unroll
                for (int ai = 0; ai < 2; ++ai)
#pragma unroll
                    for (int m = 0; m < 4; ++m) { const int row = u.pm * 256 + EPI_ROWS(ai, m); const float rs = rstd_of((float)rg[ai][m] * (1.0f / 1048576.0f)) * (1.0f / (F8_SA * F8_SW));
#pragma unroll
                        for (int n = 0; n < 2; ++n) { const int c0 = 32 * wc + 8 * fq + 4 * n;
                            if (c0 < 48) { f32x4 gv;
#pragma unroll
                                for (int j = 0; j < 4; ++j) gv[j] = sigmoidf_(acc[ai][0][m][n][j] * rs + bgv[n][j]);
                                *(f32x4*)(gates + (size_t)row * 48 + c0) = gv; } } }
            }
            return;
        }
        const bool isq = pn >= 6, normed = isq || pn == 2 || pn == 4;
        const float* gn = isq ? qnorm : knorm + (pn == 2 ? 64 : 128);
        f32x4 gv[2][2];
#pragma unroll
        for (int bj = 0; bj < 2; ++bj) { gv[bj][0] = *(const f32x4*)(gn + 32 * bj + 8 * fq); gv[bj][1] = *(const f32x4*)(gn + 32 * bj + 8 * fq + 4); }
        const float post = isq ? 0.125f : 1.0f;
        float rsf[2][4];
        { unsigned long long rsv[2][4];
#pragma unroll
          for (int ai = 0; ai < 2; ++ai)
#pragma unroll
              for (int m = 0; m < 4; ++m) rsv[ai][m] = ssq[u.pm * 256 + EPI_ROWS(ai, m)];
#pragma unroll
          for (int ai = 0; ai < 2; ++ai)
#pragma unroll
              for (int m = 0; m < 4; ++m) rsf[ai][m] = rstd_of((float)rsv[ai][m] * (1.0f / 1048576.0f)) * (1.0f / (F8_SA * F8_SW)); }
#pragma unroll
        for (int ai = 0; ai < 2; ++ai)
#pragma unroll
            for (int m = 0; m < 4; ++m) { const int row = u.pm * 256 + EPI_ROWS(ai, m); const float rs = rsf[ai][m];
                f32x4 v[2][2]; float ss = 0.f;
#pragma unroll
                for (int bj = 0; bj < 2; ++bj) { v[bj][0] = acc[ai][bj][m][0] * rs; v[bj][1] = acc[ai][bj][m][1] * rs; ss += sq4(v[bj][0]) + sq4(v[bj][1]); }
                if (normed) { ss = xsum32(xsum16(ss)); const float r2 = __builtin_amdgcn_rsqf(ss * (1.0f / 64.0f) + EPS) * post;
#pragma unroll
                    for (int bj = 0; bj < 2; ++bj) { v[bj][0] = v[bj][0] * gv[bj][0] * r2; v[bj][1] = v[bj][1] * gv[bj][1] * r2; } }
                if (pn == 3 || pn == 5) {
                    const int b = row >> 13, s0 = row & 8191, s = (s0 & ~12) | ((s0 & 4) << 1) | ((s0 & 8) >> 1); bf16* vt = (pn == 3 ? vsel : vwin) + ((size_t)(b * 4 + wc) * 64 + 8 * fq) * SEQ + s;
#pragma unroll
                    for (int bj = 0; bj < 2; ++bj)
#pragma unroll
                        for (int n = 0; n < 2; ++n)
#pragma unroll
                            for (int j = 0; j < 4; ++j) vt[(size_t)(32 * bj + 4 * n + j) * SEQ] = (bf16)f2bf(v[bj][n][j]);
                } else {
                bf16* dst;
                if (isq) dst = q + (size_t)row * D + ((pn - 6) * 4 + wc) * 64;
                else { const int b = row >> 13, s = row & 8191; bf16* kvb = pn == 0 ? kc : pn == 1 ? vc : pn == 2 ? ksel : kwin; dst = kvb + ((size_t)(b * 4 + wc) * SEQ + s) * 64; }
#pragma unroll
                for (int bj = 0; bj < 2; ++bj) *(u32x4*)(dst + 32 * bj + 8 * fq) = pack8(v[bj][0], v[bj][1]); } }
    }
};
struct EpiGates {
    const unsigned long long* ssq; float* gates; const float* bgate;
    __device__ __forceinline__ void operator()(const f32x4 (&acc)[2][2][4][2], const Unit& u, int wr, int wc, int fr, int fq) const {
        if (wc >= 2) return;
        float bgv[2][4]; unsigned long long rg[2][4];
#pragma unroll
        for (int n = 0; n < 2; ++n)
#pragma unroll
            for (int j = 0; j < 4; ++j) { const int c = 32 * wc + 8 * fq + 4 * n + j; bgv[n][j] = bgate[c < 48 ? c : 47]; }
#pragma unroll
        for (int ai = 0; ai < 2; ++ai)
#pragma unroll
            for (int m = 0; m < 4; ++m) rg[ai][m] = ssq[u.pm * 256 + EPI_ROWS(ai, m)];
#pragma unroll
        for (int ai = 0; ai < 2; ++ai)
#pragma unroll
            for (int m = 0; m < 4; ++m) { const int row = u.pm * 256 + EPI_ROWS(ai, m); const float rs = rstd_of((float)rg[ai][m] * (1.0f / 1048576.0f)) * (1.0f / (F8_SA * F8_SW));
#pragma unroll
                for (int n = 0; n < 2; ++n) { const int c0 = 32 * wc + 8 * fq + 4 * n;
                    if (c0 < 48) { f32x4 gv;
#pragma unroll
                        for (int j = 0; j < 4; ++j) gv[j] = sigmoidf_(acc[ai][0][m][n][j] * rs + bgv[n][j]);
                        *(f32x4*)(gates + (size_t)row * 48 + c0) = gv; } } }
    }
};
struct EpiCmp {
    bf16* hid; const float* cb1; int nMh;
    __device__ __forceinline__ void operator()(const f32x4 (&acc)[2][2][4][2], const Unit& u, int wr, int wc, int fr, int fq) const {
        f32x4 b[2][2];
#pragma unroll
        for (int bj = 0; bj < 2; ++bj) { const float* bp = cb1 + u.e * 256 + EPI_COL(bj); b[bj][0] = *(const f32x4*)bp; b[bj][1] = *(const f32x4*)(bp + 4); }
#pragma unroll
        for (int ai = 0; ai < 2; ++ai)
#pragma unroll
            for (int m = 0; m < 4; ++m) { const int row = (u.pm - u.e * nMh) * 256 + EPI_ROWS(ai, m);
#pragma unroll
                for (int bj = 0; bj < 2; ++bj) { f32x4 v0 = acc[ai][bj][m][0] + b[bj][0], v1 = acc[ai][bj][m][1] + b[bj][1];
#pragma unroll
                    for (int j = 0; j < 4; ++j) { v0[j] = gelu_tanh(v0[j]); v1[j] = gelu_tanh(v1[j]); }
                    *(u32x4*)(hid + ((size_t)u.e * 8192 + row) * 256 + EPI_COL(bj)) = pack8(v0, v1); } }
    }
};

__device__ __forceinline__ void p2_spatial(Frame& F) {
    unsigned char* ws = F.ws;
    bf16* U = (bf16*)(ws + WS_U); const bf16* V = (const bf16*)(ws + WS_V); const float* lnp = (const float*)(ws + WS_LNP); const bf16* WAS = (const bf16*)(ws + WS_WAS);
    const float* lng = F.in[I_ALNG]; const float* lnb = F.in[I_ALNB]; const float* bs = F.in[I_ABS];
    LAS bf16* vt = (LAS bf16*)F.lds;
    LAS float* st = (LAS float*)(F.lds + 256 * 272);
    const int tid = (F.wave * 64 + lane_id()), lane = lane_id(), w = F.wave, r32 = lane & 31, h = lane >> 5, dp = w & 3, tp = w >> 2;
    bf16x8 bw[8][2]; int gl = -1;
#pragma unroll
    for (int ks = 0; ks < 8; ++ks) { bw[ks][0] = (bf16x8){0, 0, 0, 0, 0, 0, 0, 0}; bw[ks][1] = bw[ks][0]; }
    for (int unit = F.bx; unit < 2048; unit += F.G) {
        const int c = unit >> 3, g = unit & 7, row0 = c * 128;
        if (g != gl) {
#pragma unroll
            for (int ks = 0; ks < 8; ++ks)
#pragma unroll
                for (int x = 0; x < 2; ++x) bw[ks][x] = (ks < 4 * tp + 4) ? *(const bf16x8*)(WAS + ((size_t)(g * 128 + 32 * (2 * tp + x) + r32)) * 128 + 16 * ks + 8 * h) : bw[ks][x];
            gl = g; }
        __syncthreads();
        if (tid < 128) { const f32x4* p = (const f32x4*)(lnp + (size_t)(row0 + tid) * 64); float s1 = 0.f, s2 = 0.f;
#pragma unroll
            for (int k = 0; k < 16; ++k) { const f32x4 v = p[k]; s1 += v.x + v.z; s2 += v.y + v.w; }
            const float mu = s1 * (1.0f / GD), var = s2 * (1.0f / GD) - mu * mu; st[tid * 2] = mu; st[tid * 2 + 1] = __builtin_amdgcn_rsqf(fmaxf(var, 0.f) + EPS); }
        __syncthreads();
        { LAS unsigned char* stg = F.lds + 70656 + w * 9216;
#pragma unroll
          for (int it = 0; it < 8; ++it) { const int rr = 2 * it + (lane >> 5), ch = lane & 31;
              *(LAS u32x4*)(stg + rr * 528 + ch * 16) = *(const u32x4*)(V + (size_t)(row0 + 16 * w + rr) * GD + g * 256 + ch * 8); }
          LDS_WAIT(); asm volatile("" ::: "memory");
          const int sl = lane & 15, s = 16 * w + sl; const float mu = st[s * 2], rs = st[s * 2 + 1];
#pragma unroll 2
          for (int it = 0; it < 8; ++it) { const int ch = (lane >> 4) + 4 * it, d0 = ch * 8; const u32x4 raw = *(const LAS u32x4*)(stg + sl * 528 + ch * 16);
              const f32x4 g0 = *(const f32x4*)(lng + g * 256 + d0), g1 = *(const f32x4*)(lng + g * 256 + d0 + 4), b0 = *(const f32x4*)(lnb + g * 256 + d0), b1 = *(const f32x4*)(lnb + g * 256 + d0 + 4);
              const unsigned rw[4] = {raw.x, raw.y, raw.z, raw.w};
#pragma unroll
              for (int j = 0; j < 4; ++j) { const float ga = j < 2 ? g0[2 * j] : g1[2 * j - 4], gb = j < 2 ? g0[2 * j + 1] : g1[2 * j - 3], ba = j < 2 ? b0[2 * j] : b1[2 * j - 4], bb = j < 2 ? b0[2 * j + 1] : b1[2 * j - 3];
                  vt[(d0 + 2 * j) * 136 + s] = (bf16)f2bf((bflo(rw[j]) - mu) * rs * ga + ba); vt[(d0 + 2 * j + 1) * 136 + s] = (bf16)f2bf((bfhi(rw[j]) - mu) * rs * gb + bb); } }
          LDS_WAIT(); asm volatile("" ::: "memory"); }
        __syncthreads();
        f32x16 acc[2][2];
#pragma unroll
        for (int a = 0; a < 2; ++a)
#pragma unroll
            for (int b = 0; b < 2; ++b)
#pragma unroll
                for (int k = 0; k < 16; ++k) acc[a][b][k] = 0.f;
#pragma unroll
        for (int ks = 0; ks < 8; ++ks) {
            if (ks < 4 * tp + 4) {
                bf16x8 a[2];
#pragma unroll
                for (int x = 0; x < 2; ++x) a[x] = *(const LAS bf16x8*)(vt + (32 * (2 * dp + x) + r32) * 136 + 16 * ks + 8 * h);
#pragma unroll
                for (int x = 0; x < 2; ++x)
#pragma unroll
                    for (int y = 0; y < 2; ++y) acc[x][y] = __builtin_amdgcn_mfma_f32_32x32x16_bf16(a[x], bw[ks][y], acc[x][y], 0, 0, 0);
            } }
        { LAS unsigned char* stg = F.lds + 70656 + w * 9216;
#pragma unroll
          for (int y = 0; y < 2; ++y) { const float bsv = bs[g * 128 + 32 * (2 * tp + y) + r32];
#pragma unroll
              for (int x = 0; x < 2; ++x)
#pragma unroll
                  for (int jj = 0; jj < 4; ++jj) { u32x2 o; o.x = pk2(acc[x][y][jj * 4 + 0] + bsv, acc[x][y][jj * 4 + 1] + bsv); o.y = pk2(acc[x][y][jj * 4 + 2] + bsv, acc[x][y][jj * 4 + 3] + bsv);
                      *(LAS u32x2*)(stg + (32 * y + r32) * 144 + (32 * x + 8 * jj + 4 * h) * 2) = o; } }
          LDS_WAIT(); asm volatile("" ::: "memory");
          const int rr = lane >> 3, ch = lane & 7; const size_t gofs = (size_t)(row0 + 64 * tp + rr) * GD + g * 256 + 64 * dp + 8 * ch;
          bf16* G = (bf16*)(ws + WS_ACT);
#pragma unroll
          for (int it = 0; it < 8; ++it) { const u32x4 mx = *(const LAS u32x4*)(stg + (rr + 8 * it) * 144 + ch * 16); const u32x4 uu = *(const u32x4*)(U + gofs + (size_t)(8 * it) * GD); u32x4 o;
              o.x = pk2(bflo(uu.x) * bflo(mx.x), bfhi(uu.x) * bfhi(mx.x)); o.y = pk2(bflo(uu.y) * bflo(mx.y), bfhi(uu.y) * bfhi(mx.y));
              o.z = pk2(bflo(uu.z) * bflo(mx.z), bfhi(uu.z) * bfhi(mx.z)); o.w = pk2(bflo(uu.w) * bflo(mx.w), bfhi(uu.w) * bfhi(mx.w));
              *(u32x4*)(G + gofs + (size_t)(8 * it) * GD) = o; }
          LDS_WAIT(); asm volatile("" ::: "memory"); }
    }
}

__device__ __forceinline__ void p_router(Frame& F, int layer) {
    unsigned char* ws = F.ws;
    const bf16* HF = (const bf16*)(ws + WS_HF); const float* rw = F.in[I_RW] + (size_t)layer * D * NEXP; const float* rb = F.in[I_RB] + layer * NEXP; const float* gn = F.in[I_NFFN] + layer * D;
    int* lslot = (int*)(ws + WS_LSLOT); float* lw = (float*)(ws + WS_LW); float* lrs = (float*)(ws + WS_LRS);
    constexpr int WST = 1032;
    LAS bf16* Whi = (LAS bf16*)F.lds; LAS bf16* Wlo = Whi + 32 * WST;
    LAS float* lg = (LAS float*)(F.lds + 133120) + F.wave * 544;
    const int tid = (F.wave * 64 + lane_id()), lane = lane_id();
    __syncthreads();
    { f32x4 rv[16]; float gv[16];
#pragma unroll
      for (int it = 0; it < 16; ++it) { const int idx = (tid + 512 * it) * 4; rv[it] = *(const f32x4*)(rw + idx); gv[it] = gn[idx >> 5]; }
#pragma unroll
      for (int it = 0; it < 16; ++it) { const int idx = (tid + 512 * it) * 4, k = idx >> 5, e0 = idx & 31;
#pragma unroll
          for (int j = 0; j < 4; ++j) { const float v = rv[it][j] * gv[it]; const unsigned hi = f2bf(v);
              Whi[(e0 + j) * WST + k] = (bf16)hi; Wlo[(e0 + j) * WST + k] = (bf16)f2bf(v - bf2f((unsigned short)hi)); } } }
    __syncthreads();
    const int tok = lane & 15, q = lane >> 4;
    for (int grp = F.bx * NWAVES + F.wave; grp < NTOK / 16; grp += F.G * NWAVES) {
        const int t0 = grp * 16;
        f32x4 a0 = {0.f, 0.f, 0.f, 0.f}, a1 = {0.f, 0.f, 0.f, 0.f}; float ssq = 0.f;
        const bf16* hrow = HF + (size_t)(t0 + tok) * D + 8 * q;
        const LAS bf16* wrow = Whi + tok * WST + 8 * q;
#pragma unroll
        for (int jb = 0; jb < 2; ++jb) {
            u32x4 hb[16];
#pragma unroll
            for (int jj = 0; jj < 16; ++jj) hb[jj] = *(const u32x4*)(hrow + 32 * (16 * jb + jj));
#pragma unroll
            for (int jj = 0; jj < 16; ++jj) { const int j = 16 * jb + jj; const u32x4 hw = hb[jj]; const bf16x8 A = __builtin_bit_cast(bf16x8, hw);
                const float hv[8] = {bflo(hw.x), bfhi(hw.x), bflo(hw.y), bfhi(hw.y), bflo(hw.z), bfhi(hw.z), bflo(hw.w), bfhi(hw.w)};
#pragma unroll
                for (int m = 0; m < 8; ++m) ssq += hv[m] * hv[m];
                const LAS bf16* wp = wrow + 32 * j;
                const bf16x8 bh0 = *(const LAS bf16x8*)wp, bl0 = *(const LAS bf16x8*)(wp + 32 * WST), bh1 = *(const LAS bf16x8*)(wp + 16 * WST), bl1 = *(const LAS bf16x8*)(wp + 48 * WST);
                a0 = __builtin_amdgcn_mfma_f32_16x16x32_bf16(A, bh0, a0, 0, 0, 0); a0 = __builtin_amdgcn_mfma_f32_16x16x32_bf16(A, bl0, a0, 0, 0, 0);
                a1 = __builtin_amdgcn_mfma_f32_16x16x32_bf16(A, bh1, a1, 0, 0, 0); a1 = __builtin_amdgcn_mfma_f32_16x16x32_bf16(A, bl1, a1, 0, 0, 0); }
        }
        ssq = xsum32(xsum16(ssq));
#pragma unroll
        for (int i = 0; i < 4; ++i) { lg[(4 * q + i) * 32 + tok] = a0[i]; lg[(4 * q + i) * 32 + 16 + tok] = a1[i]; }
        if (q == 0) lg[512 + tok] = rstd_of(ssq);
        LDS_WAIT(); asm volatile("" ::: "memory");
        if (lane < 16) {
            const float rs = lg[512 + lane]; float v[4] = {-3.0e38f, -3.0e38f, -3.0e38f, -3.0e38f}; int ix[4] = {0, 0, 0, 0};
            for (int e = 0; e < 32; ++e) { const float x = lg[lane * 32 + e] * rs + rb[e];
                if (x > v[3]) { v[3] = x; ix[3] = e;
                    if (v[3] > v[2]) { float tv = v[2]; v[2] = v[3]; v[3] = tv; int ti = ix[2]; ix[2] = ix[3]; ix[3] = ti;
                        if (v[2] > v[1]) { tv = v[1]; v[1] = v[2]; v[2] = tv; ti = ix[1]; ix[1] = ix[2]; ix[2] = ti;
                            if (v[1] > v[0]) { tv = v[0]; v[0] = v[1]; v[1] = tv; ti = ix[0]; ix[0] = ix[1]; ix[1] = ti; } } } } }
            float ex[4], sum = 0.f;
#pragma unroll
            for (int k = 0; k < 4; ++k) { ex[k] = __expf(v[k] - v[0]); sum += ex[k]; }
            const float inv = 1.0f / sum; const int t = t0 + lane;
#pragma unroll
            for (int k = 0; k < 4; ++k) { const int e = ix[k]; const unsigned pos = __hip_atomic_fetch_add(F.ctl + CW_CNT + (layer * 32 + e) * 64, 1u, __ATOMIC_RELAXED, __HIP_MEMORY_SCOPE_AGENT);
                lslot[(size_t)e * NTOK + pos] = t * 4 + k; lw[(size_t)e * NTOK + pos] = ex[k] * inv; lrs[(size_t)e * NTOK + pos] = rs; }
        }
        LDS_WAIT(); asm volatile("" ::: "memory");
    }
    __syncthreads();
}

__device__ __forceinline__ void p_combine(Frame& F, unsigned char* hq, float* ssq1) {
    unsigned char* ws = F.ws; const bf16* HF = (const bf16*)(ws + WS_HF); bf16* HR = (bf16*)(ws + WS_HB0); const unsigned char* Y = ws + WS_Y;
    const int gw = F.bx * NWAVES + F.wave, NGW = F.G * NWAVES, lane = lane_id();
    for (int m0 = gw; m0 < NTOK; m0 += 2 * NGW) {
        f32x4 v[2][4]; unsigned yy[2][4][4];
#pragma unroll
        for (int r = 0; r < 2; ++r) { const int m = (m0 + r * NGW) < NTOK ? m0 + r * NGW : m0; const u32x2* hr = (const u32x2*)(HF + (size_t)m * D) + lane;
#pragma unroll
            for (int j = 0; j < 4; ++j) { const u32x2 hw = hr[64 * j]; v[r][j] = (f32x4){bflo(hw.x), bfhi(hw.x), bflo(hw.y), bfhi(hw.y)};
#pragma unroll
                for (int k = 0; k < 4; ++k) yy[r][j][k] = *((const unsigned*)(Y + ((size_t)m * 4 + k) * D) + lane + 64 * j); } }
#pragma unroll
        for (int r = 0; r < 2; ++r) { const int m = (m0 + r * NGW) < NTOK ? m0 + r * NGW : m0; float s = 0.f;
#pragma unroll
            for (int j = 0; j < 4; ++j) {
#pragma unroll
                for (int k = 0; k < 4; ++k) { const f32x2 lo = __builtin_amdgcn_cvt_pk_f32_fp8((int)yy[r][j][k], false), hi = __builtin_amdgcn_cvt_pk_f32_fp8((int)yy[r][j][k], true);
                    v[r][j].x += lo.x * (1.0f / F8_SY); v[r][j].y += lo.y * (1.0f / F8_SY); v[r][j].z += hi.x * (1.0f / F8_SY); v[r][j].w += hi.y * (1.0f / F8_SY); }
                s += sq4(v[r][j]); }
            s = wave_sum(s);
            u32x2* o8 = (u32x2*)(HR + (size_t)m * D) + lane; unsigned* o4 = (unsigned*)(hq + (size_t)m * D) + lane;
#pragma unroll
            for (int j = 0; j < 4; ++j) { o8[64 * j] = (u32x2){pk2(v[r][j].x, v[r][j].y), pk2(v[r][j].z, v[r][j].w)}; const f32x4 qv = v[r][j] * F8_SA; o4[64 * j] = pk4_fp8(qv.x, qv.y, qv.z, qv.w); }
            if (lane == 0) ssq1[m] = s; }
    }
}

__device__ __forceinline__ void p11_compress2(Frame& F) {
    unsigned char* ws = F.ws; const bf16* HID = (const bf16*)(ws + WS_HID); bf16* KCMP = (bf16*)(ws + WS_KCMP); bf16* VTCMP = (bf16*)(ws + WS_VTCMP);
    const float* knorm = F.in[I_KNORM];
    LAS float* w2 = (LAS float*)F.lds;
    const int tid = (F.wave * 64 + lane_id());
    int jl = -1;
    for (int unit = F.bx; unit < 256; unit += F.G) {
        const int j = unit >> 7, rb = unit & 127;
        if (j != jl) { __syncthreads(); const f32x4* src = (const f32x4*)(F.in[I_CMPW2] + (size_t)j * 256 * 64); f32x4 wv[8];
#pragma unroll
            for (int i = 0; i < 8; ++i) wv[i] = src[tid + NTHR * i];
#pragma unroll
            for (int i = 0; i < 8; ++i) ((LAS f32x4*)w2)[tid + NTHR * i] = wv[i];
            __syncthreads(); jl = j; }
        const int row = tid >> 3, dg = tid & 7, R = rb * 64 + row;
        const bf16* hr = HID + ((size_t)j * 8192 + R) * 256;
        float o[8] = {0.f, 0.f, 0.f, 0.f, 0.f, 0.f, 0.f, 0.f};
        u32x4 hall[32];
#pragma unroll
        for (int f8 = 0; f8 < 32; ++f8) hall[f8] = *(const u32x4*)(hr + f8 * 8);
#pragma unroll
        for (int f8 = 0; f8 < 32; ++f8) { const u32x4 hv = hall[f8]; const unsigned hw[4] = {hv.x, hv.y, hv.z, hv.w};
#pragma unroll
            for (int jj = 0; jj < 8; ++jj) { const float hval = (jj & 1) ? bfhi(hw[jj >> 1]) : bflo(hw[jj >> 1]); const LAS float* wr_ = w2 + (f8 * 8 + jj) * 64 + dg * 8;
                const f32x4 wa = *(const LAS f32x4*)wr_, wb = *(const LAS f32x4*)(wr_ + 4);
                o[0] += hval * wa.x; o[1] += hval * wa.y; o[2] += hval * wa.z; o[3] += hval * wa.w; o[4] += hval * wb.x; o[5] += hval * wb.y; o[6] += hval * wb.z; o[7] += hval * wb.w; } }
        const int bg = R >> 9, n = R & 511; const bool pad = (n == NCMP);
        if (j == 0) { float ss = 0.f;
#pragma unroll
            for (int k = 0; k < 8; ++k) ss += o[k] * o[k];
            ss += __shfl_xor(ss, 1); ss += __shfl_xor(ss, 2); ss += __shfl_xor(ss, 4);
            const float r2 = pad ? 0.f : __builtin_amdgcn_rsqf(ss * (1.0f / 64.0f) + EPS);
            f32x4 a, b;
#pragma unroll
            for (int k = 0; k < 4; ++k) { a[k] = o[k] * r2 * knorm[dg * 8 + k]; b[k] = o[4 + k] * r2 * knorm[dg * 8 + 4 + k]; }
            if (pad) { a = (f32x4){0.f, 0.f, 0.f, 0.f}; b = a; }
            *(u32x4*)(KCMP + (size_t)R * 64 + dg * 8) = pack8(a, b);
        } else {
#pragma unroll
            for (int k = 0; k < 8; ++k) VTCMP[((size_t)bg * 64 + dg * 8 + k) * 512 + ((n & ~12) | ((n & 4) << 1) | ((n & 8) >> 1))] = (bf16)f2bf(pad ? 0.f : o[k]);
        }
    }
}

constexpr int TABW = 1644;
constexpr int AT_RING = 0, AT_SLOT = 16384, AT_IMPG = 65536, AT_IMPH = AT_IMPG + 32768, AT_TABD = AT_IMPH + 32768, AT_NEG = AT_TABD + 4 * TABW * 4, AT_SELM = AT_NEG + 512, AT_INVL = AT_SELM + 1024, AT_END = AT_INVL + 1024;
static_assert(AT_END <= LDS_BYTES - 256, "attention LDS map");
__device__ __forceinline__ int t5_bucket_dev(int n) {
    if (n < 16) return n;
    int b = 16;
    b += n >= 22; b += n >= 30; b += n >= 40; b += n >= 54; b += n >= 73; b += n >= 99; b += n >= 134; b += n >= 182; b += n >= 246; b += n >= 332; b += n >= 450; b += n >= 609; b += n >= 825; b += n >= 1117; b += n >= 1513;
    return b;
}
__device__ __forceinline__ void at_stage(LAS unsigned char* lds, int slot, const bf16* k, const bf16* vt, int vt_ld, int w, int lane) {
    const int row = 8 * w + (lane >> 3), ch = (lane & 7) ^ ((row >> 1) & 7);
    __builtin_amdgcn_global_load_lds((const unsigned*)(k + (size_t)row * 64 + ch * 8), (LAS unsigned*)(lds + AT_RING + slot * AT_SLOT + w * 1024), 16, 0, 0);
    __builtin_amdgcn_global_load_lds((const unsigned*)(vt + (size_t)row * vt_ld + ch * 8), (LAS unsigned*)(lds + AT_RING + slot * AT_SLOT + 8192 + w * 1024), 16, 0, 0);
}
__device__ __forceinline__ f32x16 at_scores(const LAS unsigned char* blk, int kt, int r32, int h, const bf16x8 (&qf)[4]) {
    f32x16 st;
#pragma unroll
    for (int k = 0; k < 16; ++k) st[k] = 0.f;
    const int row = 32 * kt + r32, sw = (row >> 1) & 7;
#pragma unroll
    for (int ks = 0; ks < 4; ++ks) { const bf16x8 a = *(const LAS bf16x8*)(blk + row * 128 + (((2 * ks + h) ^ sw) << 4)); st = __builtin_amdgcn_mfma_f32_32x32x16_bf16(a, qf[ks], st, 0, 0, 0); }
    return st;
}
__device__ __forceinline__ unsigned cvt_pk_bf16(float lo, float hi) { unsigned r; asm volatile("v_cvt_pk_bf16_f32 %0, %1, %2" : "=v"(r) : "v"(lo), "v"(hi)); return r; }
__device__ __forceinline__ bf16x8 at_packp(const f32x16& p, int m) {
    const u32x4 w = {cvt_pk_bf16(p[8 * m + 0], p[8 * m + 1]), cvt_pk_bf16(p[8 * m + 2], p[8 * m + 3]), cvt_pk_bf16(p[8 * m + 4], p[8 * m + 5]), cvt_pk_bf16(p[8 * m + 6], p[8 * m + 7])};
    return __builtin_bit_cast(bf16x8, w);
}
__device__ __forceinline__ void at_pv(const LAS unsigned char* blk, int kt, int r32, int h, const f32x16& p, f32x16 (&o)[2]) {
#pragma unroll
    for (int m = 0; m < 2; ++m) { const bf16x8 pb = at_packp(p, m);
#pragma unroll
        for (int dt = 0; dt < 2; ++dt) { const int d = 32 * dt + r32, sw = (d >> 1) & 7;
            const bf16x8 a = *(const LAS bf16x8*)(blk + 8192 + d * 128 + (((4 * kt + 2 * m + h) ^ sw) << 4));
            o[dt] = __builtin_amdgcn_mfma_f32_32x32x16_bf16(a, pb, o[dt], 0, 0, 0); } }
}
template <int STEP> __device__ __forceinline__ void at_softmax(f32x16& st, int cls, int dl, const LAS float* tabr, const LAS float* negr, int wlim, bool lane_ok) {
    constexpr float L2E = 1.44269504089f;
    if (cls == 0) { const float tb = lane_ok ? tabr[1513] : -1.0e30f;
#pragma unroll
        for (int k = 0; k < 16; ++k) st[k] = fast_exp2(st[k] * L2E + tb);
    } else if (cls == 1) { const LAS float* tq = (lane_ok ? tabr + dl : negr + 64 * STEP) - 27 * STEP; asm("" : "+v"(tq));
#pragma unroll
        for (int k = 0; k < 16; ++k) st[k] = fast_exp2(st[k] * L2E + tq[STEP * (27 - (8 * (k >> 2) + (k & 3)))]);
    } else {
        float tb[16]; const LAS float* tq = tabr + dl - 27 * STEP; asm("" : "+v"(tq));
#pragma unroll
        for (int k = 0; k < 16; ++k) { const int d = dl - STEP * (8 * (k >> 2) + (k & 3));
            if (STEP == 1) tb[k] = tq[27 - (8 * (k >> 2) + (k & 3))];
            else { const int dc = d < 0 ? 0 : (d > 1513 ? 1513 : d); tb[k] = tabr[dc]; } }
#pragma unroll
        for (int k = 0; k < 16; ++k) { const int d = dl - STEP * (8 * (k >> 2) + (k & 3)); const bool ok = lane_ok && (unsigned)d < (unsigned)wlim;
            st[k] = fast_exp2(st[k] * L2E + (ok ? tb[k] : -1.0e30f)); }
    }
}
__device__ __forceinline__ int at_class(int dmin, int dmax, int wlim) { return dmin >= 1513 && dmax < wlim ? 0 : ((dmin >= 0 && dmax <= 1640 && dmax < wlim) ? 1 : 2); }
__device__ __forceinline__ float fadd_(float a, float b) { float r; asm("v_add_f32 %0, %1, %2" : "=v"(r) : "v"(a), "v"(b)); return r; }
__device__ __forceinline__ float at_sum16(const f32x16& p) { return fadd_(fadd_(fadd_(fadd_(p[0], p[1]), fadd_(p[2], p[3])), fadd_(fadd_(p[4], p[5]), fadd_(p[6], p[7]))), fadd_(fadd_(fadd_(p[8], p[9]), fadd_(p[10], p[11])), fadd_(fadd_(p[12], p[13]), fadd_(p[14], p[15])))); }
#define AT_WAITV(n) asm volatile("s_waitcnt vmcnt(" #n ")" ::: "memory")
#define AT_BAR() do { asm volatile("" ::: "memory"); __builtin_amdgcn_s_barrier(); asm volatile("" ::: "memory"); } while (0)

__device__ __forceinline__ void p12_attention(Frame& F) {
    unsigned char* ws = F.ws; LAS unsigned char* lds = F.lds;
    const bf16* Q = (const bf16*)(ws + WS_Q); const float* GATES = (const float*)(ws + WS_GATES); unsigned char* AO = ws + WS_AOQ;
    const float* relb = F.in[I_RELB];
    const int tid0 = (F.wave * 64 + lane_id()), lane0 = lane_id(), w = F.wave;
    LAS float* IMPG = (LAS float*)(lds + AT_IMPG); LAS float* IMPH = (LAS float*)(lds + AT_IMPH);
    LAS float* TABD = (LAS float*)(lds + AT_TABD); LAS unsigned* SELM = (LAS unsigned*)(lds + AT_SELM);
    constexpr float L2E = 1.44269504089f; constexpr int BIG = 1 << 30;
    const int bg = F.bx & 15, b = bg >> 2, g = bg & 3;
    const bf16* kc0 = (const bf16*)(ws + WS_KCMP) + (size_t)bg * 512 * 64; const bf16* vc0 = (const bf16*)(ws + WS_VTCMP) + (size_t)bg * 64 * 512;
    const bf16* ks0 = (const bf16*)(ws + WS_KSEL) + (size_t)bg * SEQ * 64; const bf16* vs0 = (const bf16*)(ws + WS_VTSEL) + (size_t)bg * 64 * SEQ;
    const bf16* kw0 = (const bf16*)(ws + WS_KWIN) + (size_t)bg * SEQ * 64; const bf16* vw0 = (const bf16*)(ws + WS_VTWIN) + (size_t)bg * 64 * SEQ;
    float mq = fabsf(F.in[I_QNORM][lane0]), mk = fmaxf(fabsf(F.in[I_KNORM][lane0]), fmaxf(fabsf(F.in[I_KNORM][64 + lane0]), fabsf(F.in[I_KNORM][128 + lane0]))), mb = 0.f;
#pragma unroll
    for (int k8 = 0; k8 < 8; ++k8) mb = fmaxf(mb, fabsf(relb[lane0 + 64 * k8]));
#pragma unroll
    for (int o = 1; o < 64; o <<= 1) { mq = fmaxf(mq, __shfl_xor(mq, o)); mk = fmaxf(mk, __shfl_xor(mk, o)); mb = fmaxf(mb, __shfl_xor(mb, o)); }
    const float Msh = 8.0f * mq * mk + mb;
    __syncthreads();
    { float bv[13];
#pragma unroll
      for (int it = 0; it < 13; ++it) { const int k = tid0 + NTHR * it, kc = k < 4 * TABW ? k : 0, rr = kc / TABW, d = kc % TABW; bv[it] = relb[t5_bucket_dev(d) * 16 + g * 4 + rr]; }
#pragma unroll
      for (int it = 0; it < 13; ++it) { const int k = tid0 + NTHR * it; if (k < 4 * TABW) TABD[k] = (bv[it] - Msh) * L2E; } }
    if (tid0 < 128) ((LAS float*)(lds + AT_NEG))[tid0] = -1.0e30f;
    __syncthreads();
    int kslice = 0;
    for (int un = F.bx; un < 2048; un += F.G) {
        const int i = 16 * (un >> 8) + (((un >> 8) & 1) ? 15 - ((un >> 4) & 15) : ((un >> 4) & 15));
        int tid = tid0; asm volatile("" : "+v"(tid));
        const int lane = tid & 63, r32 = lane & 31, h = lane >> 5, c = r32, r = c & 3;
        const LAS float* tabr = TABD + r * TABW; const LAS float* negr = (const LAS float*)(lds + AT_NEG);
        const int tl = 8 * w + (c >> 2), t = 64 * i + tl, head = g * 4 + r; const size_t tokrow = (size_t)b * SEQ + t;
        const int tmin = 64 * i + 8 * w, tmax = tmin + 7;
        const int nvis = (4 * i + 3) < NCMP ? (4 * i + 3) : NCMP, nst = (nvis + 63) >> 6;
#define AT_RING_BEGIN(kb, vb, ld, n) do { _Pragma("unroll") for (int _p = 0; _p < 3; ++_p) { const int _bb = _p < (n) ? _p : (n) - 1; at_stage(lds, _p, (kb) + (size_t)_bb * 64 * 64, (vb) + _bb * 64, (ld), w, lane); } } while (0)
#define AT_RING_STEP(kb, vb, ld, n, s) do { AT_WAITV(4); AT_BAR(); { const int _bb = (s) + 3 < (n) ? (s) + 3 : (n) - 1; at_stage(lds, ((s) + 3) & 3, (kb) + (size_t)_bb * 64 * 64, (vb) + _bb * 64, (ld), w, lane); } } while (0)
#define AT_RING_END() do { AT_WAITV(0); AT_BAR(); } while (0)
        AT_RING_BEGIN(kc0, vc0, 512, nst);
        bf16x8 qf[4];
#pragma unroll
        for (int ks = 0; ks < 4; ++ks) qf[ks] = *(const bf16x8*)(Q + tokrow * D + head * 64 + 16 * ks + 8 * h);
        const float gt_c = GATES[tokrow * 48 + head], gt_s = GATES[tokrow * 48 + 16 + head], gt_w = GATES[tokrow * 48 + 32 + head];
        f32x16 otot[2], obr[2];
#pragma unroll
        for (int dt = 0; dt < 2; ++dt)
#pragma unroll
            for (int k = 0; k < 16; ++k) { otot[dt][k] = 0.f; obr[dt][k] = 0.f; }
        float lsum = 0.f, hcarry = 0.f;
        LAS bf16* IMP16 = (LAS bf16*)(lds + AT_IMPG); LAS float* INVL = (LAS float*)(lds + AT_INVL);
        for (int sp = 0; sp < nst; ++sp) {
            AT_RING_STEP(kc0, vc0, 512, nst, sp);
            const LAS unsigned char* blk = lds + AT_RING + (sp & 3) * AT_SLOT;
#pragma unroll
            for (int kt = 0; kt < 2; ++kt) { const int ct = 2 * sp + kt;
                if (32 * ct < nvis) {
                    f32x16 st = at_scores(blk, kt, r32, h, qf);
                    const int cls = at_class(tmin - (512 * ct + 527), tmax - (512 * ct + 31), BIG);
                    at_softmax<16>(st, cls, t - 512 * ct - 31 - 64 * h, tabr, negr, BIG, true);
                    lsum += at_sum16(st);
                    at_pv(blk, kt, r32, h, st, obr);
                    float xh[4];
#pragma unroll
                    for (int jj = 0; jj < 4; ++jj) xh[jj] = __shfl_xor(0.5f * st[jj * 4 + 3], 32);
#pragma unroll
                    for (int jj = 0; jj < 4; ++jj) { const float gsum = (st[jj * 4] + st[jj * 4 + 1]) + (st[jj * 4 + 2] + 0.5f * st[jj * 4 + 3]);
                        const float recv = h ? xh[jj] : (jj ? xh[jj > 0 ? jj - 1 : 0] : hcarry);
                        IMP16[(r * 64 + tl) * 128 + 8 * ct + 2 * jj + h] = (bf16)f2bf(gsum + recv); }
                    hcarry = xh[3];
                } }
        }
        AT_RING_END();
        lsum += __shfl_xor(lsum, 32); const float invl = lsum > 0.f ? 1.0f / lsum : 0.f;
        if (h == 0) INVL[tl * 4 + r] = invl;
        AT_RING_BEGIN(ks0, vs0, SEQ, i + 1);
#pragma unroll
        for (int dt = 0; dt < 2; ++dt)
#pragma unroll
            for (int k = 0; k < 16; ++k) { otot[dt][k] = (gt_c * invl) * obr[dt][k]; obr[dt][k] = 0.f; }
        { const int j = lane >> 3, part = lane & 7, tj = 8 * w + j;
          unsigned m[4] = {0u, 0u, 0u, 0u};
          if (i <= 15) m[0] = (2u << i) - 1u;
          else {
              unsigned key[16];
              float imp[16];
#pragma unroll
              for (int e = 0; e < 16; ++e) imp[e] = 0.f;
#pragma unroll
              for (int rr = 0; rr < 4; ++rr) { const float il = INVL[tj * 4 + rr]; const LAS u32x4* ip = (const LAS u32x4*)(IMP16 + (rr * 64 + tj) * 128 + 16 * part); const u32x4 w0 = ip[0], w1 = ip[1];
                  const unsigned ww[8] = {w0.x, w0.y, w0.z, w0.w, w1.x, w1.y, w1.z, w1.w};
#pragma unroll
                  for (int e = 0; e < 8; ++e) { imp[2 * e] += il * bflo(ww[e]); imp[2 * e + 1] += il * bfhi(ww[e]); } }
#pragma unroll
              for (int e = 0; e < 16; ++e) { const int s = 16 * part + e; const bool okc = s >= 1 && s <= i - 2;
                  key[e] = okc ? ((__builtin_bit_cast(unsigned, imp[e]) & ~127u) | (unsigned)(127 - s)) : 0u; }
              for (int rd = 0; rd < 13; ++rd) { unsigned best = key[0];
#pragma unroll
                  for (int e = 1; e < 16; ++e) best = best > key[e] ? best : key[e];
                  { unsigned o1 = (unsigned)__builtin_amdgcn_update_dpp(0, (int)best, 0xB1, 0xF, 0xF, false); best = best > o1 ? best : o1;
                    o1 = (unsigned)__builtin_amdgcn_update_dpp(0, (int)best, 0x4E, 0xF, 0xF, false); best = best > o1 ? best : o1;
                    o1 = (unsigned)__builtin_amdgcn_update_dpp(0, (int)best, 0x141, 0xF, 0xF, false); best = best > o1 ? best : o1; }
                  const int sb = 127 - (int)(best & 127u);
#pragma unroll
                  for (int x = 0; x < 4; ++x) m[x] |= ((sb >> 5) == x) ? (1u << (sb & 31)) : 0u;
#pragma unroll
                  for (int e = 0; e < 16; ++e) key[e] = key[e] == best ? 0u : key[e]; }
              m[0] |= 1u;
#pragma unroll
              for (int x = 0; x < 4; ++x) { m[x] |= (((i - 1) >> 5) == x) ? (1u << ((i - 1) & 31)) : 0u; m[x] |= ((i >> 5) == x) ? (1u << (i & 31)) : 0u; }
          }
          if (part == 0) { SELM[tj * 4] = m[0]; SELM[tj * 4 + 1] = m[1]; SELM[tj * 4 + 2] = m[2]; SELM[tj * 4 + 3] = m[3]; }
        }
        LDS_WAIT(); asm volatile("" ::: "memory");
        unsigned sm[4];
#pragma unroll
        for (int x = 0; x < 4; ++x) sm[x] = SELM[tl * 4 + x];
        { lsum = 0.f;
          for (int s = 0; s <= i; ++s) {
              AT_RING_STEP(ks0, vs0, SEQ, i + 1, s);
              const LAS unsigned char* blk = lds + AT_RING + (s & 3) * AT_SLOT;
              const unsigned word = s < 32 ? sm[0] : s < 64 ? sm[1] : s < 96 ? sm[2] : sm[3]; const bool sel = (word >> (s & 31)) & 1u;
              if (__builtin_amdgcn_ballot_w64(sel) != 0ull) {
#pragma unroll
                  for (int kt = 0; kt < 2; ++kt) { const int pos0 = 64 * s + 32 * kt;
                      f32x16 st = at_scores(blk, kt, r32, h, qf);
                      const int cls = at_class(tmin - (pos0 + 31), tmax - pos0, BIG);
                      at_softmax<1>(st, cls, t - pos0 - 4 * h, tabr, negr, BIG, sel);
                      lsum += at_sum16(st);
                      at_pv(blk, kt, r32, h, st, obr); }
              }
          }
          AT_RING_END();
          lsum += __shfl_xor(lsum, 32); const float sc = lsum > 0.f ? gt_s / lsum : 0.f;
#pragma unroll
          for (int dt = 0; dt < 2; ++dt)
#pragma unroll
              for (int k = 0; k < 16; ++k) { otot[dt][k] += sc * obr[dt][k]; obr[dt][k] = 0.f; }
        }
        { const int p0 = (64 * i - 512) < 0 ? 0 : (64 * i - 512), nst2 = (64 * i + 64 - p0) >> 6;
          const bf16* k0 = kw0 + (size_t)p0 * 64; const bf16* v0 = vw0 + p0;
          lsum = 0.f;
          AT_RING_BEGIN(k0, v0, SEQ, nst2);
          for (int sp = 0; sp < nst2; ++sp) {
              AT_RING_STEP(k0, v0, SEQ, nst2, sp);
              const LAS unsigned char* blk = lds + AT_RING + (sp & 3) * AT_SLOT;
#pragma unroll
              for (int kt = 0; kt < 2; ++kt) { const int pos0 = p0 + 64 * sp + 32 * kt;
                  f32x16 st = at_scores(blk, kt, r32, h, qf);
                  const int cls = at_class(tmin - (pos0 + 31), tmax - pos0, 512);
                  at_softmax<1>(st, cls, t - pos0 - 4 * h, tabr, negr, 512, true);
                  lsum += at_sum16(st);
                  at_pv(blk, kt, r32, h, st, obr); }
          }
          AT_RING_END();
          lsum += __shfl_xor(lsum, 32); const float sc = lsum > 0.f ? gt_w / lsum : 0.f;
#pragma unroll
          for (int dt = 0; dt < 2; ++dt)
#pragma unroll
              for (int k = 0; k < 16; ++k) otot[dt][k] += sc * obr[dt][k];
        }
        unsigned char* orow = AO + tokrow * D + head * 64;
#pragma unroll
        for (int dt = 0; dt < 2; ++dt)
#pragma unroll
            for (int jj = 0; jj < 4; ++jj) *(unsigned*)(orow + 32 * dt + 8 * jj + 4 * h) = pk4_fp8(otot[dt][jj * 4] * F8_SA, otot[dt][jj * 4 + 1] * F8_SA, otot[dt][jj * 4 + 2] * F8_SA, otot[dt][jj * 4 + 3] * F8_SA);
        conv_l1_slice(F, kslice, (LAS float*)(lds + w * 8448)); ++kslice;
        LDS_WAIT(); AT_BAR();
    }
    for (; kslice * F.G * NWAVES < 16384; ++kslice) conv_l1_slice(F, kslice, (LAS float*)(lds + w * 8448));
#undef AT_RING_BEGIN
#undef AT_RING_STEP
#undef AT_RING_END
    __syncthreads();
}

constexpr int N_PHASES = 19;
struct Args { const float* in[31]; float* out; unsigned char* ws; int ph_lo, ph_hi, li, pad; };
__global__ void __launch_bounds__(NTHR, 2) trunk_fwd(Args args) {
    extern __shared__ __attribute__((aligned(16))) unsigned char lds_raw[];
    Frame F;
    F.lds = (LAS unsigned char*)lds_raw;
    F.wave = __builtin_amdgcn_readfirstlane((int)threadIdx.x >> 6);
    F.G = gridDim.x; F.bx = blockIdx.x; F.pw_done = 0; F.ws = args.ws; F.ctl = (unsigned*)(args.ws + WS_CTL); F.out = args.out;
    F.in = (const float* const __attribute__((address_space(4)))*)__builtin_amdgcn_kernarg_segment_ptr();
    volatile LAS unsigned* MISC = (volatile LAS unsigned*)(F.lds + LDS_MISC);
    if ((F.wave * 64 + lane_id()) < 64) MISC[(F.wave * 64 + lane_id())] = 0u;
    __syncthreads();
    XcdBarrier bar; bar.bar = F.ctl + CW_BAR + args.li * XCD_BAR_WORDS; bar.x = 0; bar.st = nullptr; bar.wave = F.wave;
    if (args.ph_hi - args.ph_lo > 1) bar = xcd_barrier_post(F.ctl + CW_BAR + args.li * XCD_BAR_WORDS, MISC + 8, F.wave);
    const int lo = args.ph_lo, hi = args.ph_hi;
    unsigned char* ws = args.ws;
#define IN(k) (lo <= (k) && (k) < hi)
#define SEAM(k) do { if (IN(k) && IN((k) + 1)) xcd_barrier(bar); } while (0)
    bf16* HF = (bf16*)(ws + WS_HF); bf16* HB0 = (bf16*)(ws + WS_HB0); bf16* HB1 = (bf16*)(ws + WS_HB1);
    float* SSQ1 = (float*)(ws + WS_SSQ1); float* SSQ16 = (float*)(ws + WS_SSQ16);

    if (IN(0)) { p0_prologue(F); } SEAM(0);

    if (IN(1)) {
        SchedPlain S; S.so.init(NTOK / 256, 16, F.G, F.bx); S.A = HB0; S.Bt = (const bf16*)(ws + WS_WAIN); S.lda = D; S.K = D;
        EpiGelu E{(bf16*)(ws + WS_U), (bf16*)(ws + WS_V), SSQ1, (float*)(ws + WS_LNP)};
        g8::gemm_phase<EpiGelu, SchedPlain, false>(F.lds, D, D, S, E, F.wave);
    } SEAM(1);

    if (IN(2)) { p2_spatial(F); } SEAM(2);

    if (IN(3)) {
        SchedPlain S; S.so.init(NTOK / 256, 4, F.G, F.bx); S.A = (const bf16*)(ws + WS_ACT); S.Bt = (const bf16*)(ws + WS_WAOUT); S.lda = GD; S.K = GD;
        EpiResid<false> E{F.in[I_X], HF, ws + WS_HQ, 1.0f};
        g8::gemm_phase<EpiResid<false>, SchedPlain, false>(F.lds, GD, GD, S, E, F.wave);
    } SEAM(3);

    if (IN(4)) { p_router(F, 0); } SEAM(4);

#define PW_TAIL(NN_) do { const int _nU = T.ntile * (NN_), _R = _nU % F.G, _nid = _R ? F.G - _R : 0; int _take = 2 * _nid; if (_take > 1024 - F.pw_done) _take = 1024 - F.pw_done; \
        if (_take > 0 && F.bx >= _R) { SchedPw S2{F.pw_done + (F.bx - _R), _nid, 2, F.pw_done + _take, (const bf16*)(ws + WS_PB), (const bf16*)(ws + WS_WPL)}; EpiPw E2{(bf16*)(ws + WS_PW)}; \
            g8::gemm_phase<EpiPw, SchedPw, false>(F.lds, PLE, PLE, S2, E2, F.wave); } \
        F.pw_done += _take; } while (0)
#define PW_REST(LIM_) do { if (F.pw_done < (LIM_)) { SchedPw S2{F.pw_done + F.bx, F.G, 1 << 20, (LIM_), (const bf16*)(ws + WS_PB), (const bf16*)(ws + WS_WPL)}; EpiPw E2{(bf16*)(ws + WS_PW)}; \
            g8::gemm_phase<EpiPw, SchedPw, false>(F.lds, PLE, PLE, S2, E2, F.wave); F.pw_done = (LIM_); } } while (0)

#define MOE_LAYER(P5, L, HBIN, SSQIN, HBOUT, SSQOUT) \
    if (IN(P5)) { const MoeTab T = moe_build_tab(F, L);   \
        SchedMoe<8, 2> S; S.init(T, F.G, F.bx); S.A = (const char*)(ws + WS_HQ); S.W = (const char*)(ws + WS_WGU) + (size_t)(L) * NEXP * 2048 * D; S.lslot = (const int*)(ws + WS_LSLOT); S.gather = 1; S.wstride = (size_t)2048 * D; S.rowb = D; \
        EpiMoe1 E{ws + WS_ACT, F.in[I_EBGU] + (size_t)(L) * NEXP * 2048, (const float*)(ws + WS_LRS)}; \
        g8::gemm_phase<EpiMoe1, SchedMoe<8, 2>, true, true>(F.lds, D / 2, D / 2, S, E, F.wave); PW_TAIL(8); } SEAM(P5); \
    if (IN(P5 + 1)) { const MoeTab T = moe_build_tab(F, L); \
        SchedMoe<4, 8> S; S.init(T, F.G, F.bx); S.A = (const char*)(ws + WS_ACT); S.W = (const char*)(ws + WS_WD) + (size_t)(L) * NEXP * D * D; S.lslot = (const int*)(ws + WS_LSLOT); S.gather = 0; S.wstride = (size_t)D * D; S.rowb = D; \
        EpiMoe2 E{ws + WS_Y, F.in[I_EBD] + (size_t)(L) * NEXP * D, (const int*)(ws + WS_LSLOT), (const float*)(ws + WS_LW), ws + WS_TRASH}; \
        g8::gemm_phase<EpiMoe2, SchedMoe<4, 8>, false, true>(F.lds, D / 2, D / 2, S, E, F.wave); PW_TAIL(4); } SEAM(P5 + 1); \
    if (IN(P5 + 2)) { PW_REST(512 * ((L) + 1)); p_combine(F, HBOUT, SSQOUT); } SEAM(P5 + 2);

    MOE_LAYER(5, 0, 0, 0, ws + WS_HQ2, SSQ1 + NTOK)

    if (IN(8)) {
        SchedPlain S; S.so.init(NTOK / 256, 4, F.G, F.bx); S.A = (const bf16*)(ws + WS_HQ2); S.Bt = (const bf16*)(ws + WS_WPG); S.lda = D / 2; S.K = D / 2;
        EpiPle<false> E{HB0, (const bf16*)(ws + WS_PW), SSQ1 + NTOK, ws + WS_HQ3, (unsigned long long*)(ws + WS_SSQ1 + 512 * 1024), nullptr};
        g8::gemm_phase<EpiPle<false>, SchedPlain, false, true>(F.lds, D / 2, D / 2, S, E, F.wave);
    } SEAM(8);

    if (IN(9)) {
        SchedPlain S; S.so.init(NTOK / 256, NKVQ / 256 - 1, F.G, F.bx); S.A = (const bf16*)(ws + WS_HQ3); S.Bt = (const bf16*)(ws + WS_WKVQ);     S.lda = D / 2; S.K = D / 2;
        EpiKvq E{(const unsigned long long*)(ws + WS_SSQ1 + 512 * 1024), (bf16*)(ws + WS_KC), (bf16*)(ws + WS_VC), (bf16*)(ws + WS_KSEL), (bf16*)(ws + WS_VTSEL), (bf16*)(ws + WS_KWIN), (bf16*)(ws + WS_VTWIN),
                 (bf16*)(ws + WS_Q), (float*)(ws + WS_GATES), F.in[I_KNORM], F.in[I_QNORM], F.in[I_BBGATE]};
        g8::gemm_phase<EpiKvq, SchedPlain, false, true>(F.lds, D / 2, D / 2, S, E, F.wave);
    } SEAM(9);

    if (IN(10)) {
        const bool split = F.G >= 128; const int nc = split ? 64 : F.G;
        if (F.bx < nc) {
            SchedPair S; S.so.init(64, 1, nc, F.bx); S.A0 = (const bf16*)(ws + WS_KC); S.A1 = (const bf16*)(ws + WS_VC); S.B0 = (const bf16*)(ws + WS_WC1); S.B1 = S.B0 + (size_t)256 * 2048; S.lda = 1024; S.K = 2048; S.nMh = 32;
            EpiCmp E{(bf16*)(ws + WS_HID), (const float*)(ws + WS_CB1), 32};
            g8::gemm_phase<EpiCmp, SchedPair, false>(F.lds, 2048, 1024, S, E, F.wave); }
        if (!split || F.bx >= nc) {
            SchedPlain S; S.so.init(NTOK / 256, 1, split ? F.G - nc : F.G, split ? F.bx - nc : F.bx); S.A = (const bf16*)(ws + WS_HQ3); S.Bt = (const bf16*)(ws + WS_WKVQ + (size_t)2560 * D); S.lda = D / 2; S.K = D / 2;
            EpiGates E{(const unsigned long long*)(ws + WS_SSQ1 + 512 * 1024), (float*)(ws + WS_GATES), F.in[I_BBGATE]};
            g8::gemm_phase<EpiGates, SchedPlain, false, true>(F.lds, D / 2, D / 2, S, E, F.wave); }
    } SEAM(10);

    if (IN(11)) { p11_compress2(F); } SEAM(11);

    if (IN(12)) { p12_attention(F); } SEAM(12);

    if (IN(13)) {
        SchedPlain S; S.so.init(NTOK / 256, 4, F.G, F.bx); S.A = (const bf16*)(ws + WS_AOQ); S.Bt = (const bf16*)(ws + WS_WO); S.lda = D / 2; S.K = D / 2;
        EpiResid<true> E{HB0, HF, ws + WS_HQ, 1.0f / (F8_SA * F8_SW)};
        g8::gemm_phase<EpiResid<true>, SchedPlain, false, true>(F.lds, D / 2, D / 2, S, E, F.wave);
    } SEAM(13);

    if (IN(14)) { p_router(F, 1); } SEAM(14);

    MOE_LAYER(15, 1, 0, 0, ws + WS_HQ2, SSQ1 + 2 * NTOK)

    if (IN(18)) {
        SchedPlain S; S.so.init(NTOK / 256, 4, F.G, F.bx); S.A = (const bf16*)(ws + WS_HQ2); S.Bt = (const bf16*)(ws + WS_WPG + (size_t)D * D); S.lda = D / 2; S.K = D / 2;
        EpiPle<true> E{HB0, (const bf16*)(ws + WS_PW) + (size_t)NTOK * D, SSQ1 + 2 * NTOK, nullptr, nullptr, F.out};
        g8::gemm_phase<EpiPle<true>, SchedPlain, false, true>(F.lds, D / 2, D / 2, S, E, F.wave);
    }
#undef IN
#undef SEAM
}

extern "C" void kernel_launch(void* const* d_in, const int* in_sizes, int n_in, void* d_out, int out_size, void* d_ws, size_t ws_size, hipStream_t stream) {
    static int grid = 0;
    if (grid == 0) {
        if (n_in != 31 || out_size != NTOK * D || ws_size < WS_END) { fprintf(stderr, "kernel_launch: unexpected problem (n_in %d, out %d, ws %zu < %zu)\n", n_in, out_size, ws_size, (size_t)WS_END); grid = -1; return; }
        int dev = 0, cus = 0, per_cu = 0;
        if (hipGetDevice(&dev) != hipSuccess || hipDeviceGetAttribute(&cus, hipDeviceAttributeMultiprocessorCount, dev) != hipSuccess) { grid = -1; return; }
        if (hipFuncSetAttribute((const void*)trunk_fwd, hipFuncAttributeMaxDynamicSharedMemorySize, LDS_BYTES) != hipSuccess) { fprintf(stderr, "kernel_launch: hipFuncSetAttribute failed\n"); grid = -1; return; }
        if (hipOccupancyMaxActiveBlocksPerMultiprocessor(&per_cu, (const void*)trunk_fwd, NTHR, LDS_BYTES) != hipSuccess || per_cu < 1)
            fprintf(stderr, "kernel_launch: occupancy query reports %d workgroups per CU\n", per_cu);
        (void)hipGetLastError();
        grid = cus;
    }
    if (grid < 0) return;
    (void)hipMemsetAsync((char*)d_ws + WS_CTL, 0, CTL_ZERO_BYTES, stream);
    Args a{};
    for (int i = 0; i < 31; ++i) a.in[i] = (const float*)d_in[i];
    a.out = (float*)d_out; a.ws = (unsigned char*)d_ws;
    const int plan[] = { PHASE_PLAN };
    constexpr int nl = (int)(sizeof(plan) / sizeof(int)) / 2;
    static_assert(nl >= 1 && nl <= 7, "at most 7 barrier regions below CW_CNT");
    for (int li = 0; li < nl; ++li) { a.ph_lo = plan[2 * li]; a.ph_hi = plan[2 * li + 1]; a.li = li; hipLaunchKernelGGL(trunk_fwd, dim3(grid), dim3(NTHR), LDS_BYTES, stream, a); }
    const hipError_t le = hipPeekAtLastError();
    if (le != hipSuccess) fprintf(stderr, "kernel_launch: launch failed: %s\n", hipGetErrorName(le));
}
```
